# Optimizing an MI355X kernel written in HIP

```python
import jax, jax.numpy as jnp
from jax import lax
import numpy as np

D_MODEL = 1024
BATCH = 32
SEQ = 2048
DEPTH = 1

CTX_LEN = 256
GRID_W = 64
EPS = 1e-6

POOL_WINDOWS = (2, 4, 8, 16)
POOL_WIDTH = D_MODEL // 2
POOL_GROUP = POOL_WIDTH // len(POOL_WINDOWS)

RET_HEADS = 4
RET_DK = 128
RET_DV = 256
RET_CHUNK = 128
ROPE_BASE = 10000.0
QK_WIDTH = RET_HEADS * RET_DK
V_WIDTH = RET_HEADS * RET_DV

OFF_POOL = 0
OFF_Q = OFF_POOL + POOL_WIDTH
OFF_K = OFF_Q + QK_WIDTH
OFF_V = OFF_K + QK_WIDTH
OFF_G = OFF_V + V_WIDTH
OFF_MERGE = OFF_G + V_WIDTH
IN_WIDTH = OFF_MERGE + 2 * D_MODEL

PEER_HEADS = 8
PEER_NKEYS = 128
PEER_EXPERTS = PEER_NKEYS * PEER_NKEYS
PEER_TOPK = 16
PEER_DQ = 256
PEER_BLOCK = 128

kernel_name = "hybrid_pool_retention_peer_dit"


def rmsnorm(x, g):
    xf = x.astype(jnp.float32)
    y = xf * lax.rsqrt(jnp.mean(xf * xf, axis=-1, keepdims=True) + EPS)
    return (y * g.astype(jnp.float32)).astype(x.dtype)


def modulate(h, shift, scale):
    return h * (1.0 + scale) + shift


def heads(a, d):
    b, l, _ = a.shape
    return a.reshape(b, l, -1, d).transpose(0, 2, 1, 3)


def axial_rope(a, row, col):
    quarter = a.shape[-1] // 4
    inv = ROPE_BASE ** (-jnp.arange(quarter, dtype=jnp.float32) / quarter)
    ang = jnp.concatenate([row[:, None] * inv, col[:, None] * inv], axis=-1)
    cos, sin = jnp.cos(ang), jnp.sin(ang)
    a1, a2 = jnp.split(a, 2, axis=-1)
    return jnp.concatenate([a1 * cos - a2 * sin, a1 * sin + a2 * cos], axis=-1).astype(a.dtype)


def multiscale_pool(p, pool_w, pool_scale):
    L = p.shape[1]
    pf = p.astype(jnp.float32)
    cs = jnp.pad(jnp.cumsum(pf, axis=1), ((0, 0), (1, 0), (0, 0)))
    t = jnp.arange(L)
    groups = []
    for gi, w in enumerate(POOL_WINDOWS):
        lo = jnp.clip(t - w // 2, 0, L)
        hi = jnp.clip(t + w - w // 2, 0, L)
        sl = slice(gi * POOL_GROUP, (gi + 1) * POOL_GROUP)
        win_sum = cs[:, hi, sl] - cs[:, lo, sl]
        cnt = (hi - lo).astype(jnp.float32)[None, :, None]
        groups.append(win_sum / cnt - pf[:, :, sl])
    d = jnp.stack(groups, axis=2).astype(p.dtype)
    mixed = jnp.einsum('blgc,gcd->blgd', d, pool_w).reshape(p.shape)
    return mixed * pool_scale


def retention_scan(q, k, v, log_gamma, s0, strict):
    b, h, L, _ = q.shape
    dv = v.shape[-1]
    C = RET_CHUNK
    n = L // C

    def chunks(a):
        return a.reshape(b, h, n, C, a.shape[-1]).transpose(2, 0, 1, 3, 4)

    idx = jnp.arange(C, dtype=jnp.float32)
    rel = idx[:, None] - idx[None, :]
    mask = (rel > 0) if strict else (rel >= 0)
    lg = log_gamma[:, None, None]
    intra = jnp.where(mask, jnp.exp(lg * jnp.where(mask, rel, 0.0)), 0.0)
    q_dec = jnp.exp(log_gamma[:, None] * (idx + 1.0))[..., None]
    k_dec = jnp.exp(log_gamma[:, None] * (C - 1.0 - idx))[..., None]
    blk_dec = jnp.exp(log_gamma * C)[:, None, None]

    def step(s, qkv):
        qi, ki, vi = qkv
        scores = jnp.einsum('bhnd,bhmd->bhnm', qi, ki) * intra
        y = (jnp.einsum('bhnm,bhme->bhne', scores, vi)
             + jnp.einsum('bhnd,bhde->bhne', qi * q_dec, s))
        s = s * blk_dec + jnp.einsum('bhmd,bhme->bhde', ki * k_dec, vi)
        return s, y

    _, ys = lax.scan(step, s0, (chunks(q), chunks(k), chunks(v)))
    return ys.transpose(1, 2, 0, 3, 4).reshape(b, h, L, dv)


def context_states(kc, vc, lg):
    Lc = kc.shape[2]
    m = jnp.arange(Lc, dtype=jnp.float32)
    w_f = jnp.exp(lg[0][:, None] * (Lc - 1.0 - m))
    w_b = jnp.exp(lg[1][:, None] * m)
    kf = kc.astype(jnp.float32)
    vf = vc.astype(jnp.float32)
    s_f = jnp.einsum('hm,bhmd,bhme->bhde', w_f, kf, vf)
    s_b = jnp.einsum('hm,bhmd,bhme->bhde', w_b, kf, vf)
    return s_f, s_b


def bidir_retention(q, k, v, lg, s_f, s_b):
    y_f = retention_scan(q, k, v, lg[0], s_f, False)
    y_b = retention_scan(jnp.flip(q, 2), jnp.flip(k, 2), jnp.flip(v, 2), lg[1], s_b, True)
    return y_f + jnp.flip(y_b, 2)


def retention_out(y, gate, norm_g, w_o):
    b, h, L, dv = y.shape
    yf = y.astype(jnp.float32)
    mu = jnp.mean(yf, axis=-1, keepdims=True)
    var = jnp.mean(jnp.square(yf - mu), axis=-1, keepdims=True)
    yn = ((yf - mu) * lax.rsqrt(var + EPS)).transpose(0, 2, 1, 3).reshape(b, L, h * dv)
    yn = (yn * norm_g.astype(jnp.float32)).astype(gate.dtype)
    return (yn * jax.nn.silu(gate)) @ w_o


def mix_tokens(proj, y_ret, lp):
    pool = multiscale_pool(proj[..., OFF_POOL:OFF_Q], lp['pool_w'], lp['pool_scale']) @ lp['pool_out']
    ret = retention_out(y_ret, proj[..., OFF_G:OFF_MERGE], lp['ret_norm_g'], lp['ret_out'])
    g_pool, g_ret = jnp.split(proj[..., OFF_MERGE:], 2, axis=-1)
    merged = jax.nn.sigmoid(g_pool) * pool + jax.nn.sigmoid(g_ret) * ret
    return merged @ lp['w_out']


def peer_ffn(h, wq, keys, u, v):
    b, L, d = h.shape
    blocks = h.reshape(-1, PEER_BLOCK, d)

    def one_block(hb):
        t = hb.shape[0]
        q = (hb @ wq).reshape(t, PEER_HEADS, 2, PEER_DQ // 2)
        s = jnp.einsum('thpd,hpkd->thpk', q, keys).astype(jnp.float32)
        s1, i1 = lax.top_k(s[:, :, 0], PEER_TOPK)
        s2, i2 = lax.top_k(s[:, :, 1], PEER_TOPK)
        cand = (s1[..., :, None] + s2[..., None, :]).reshape(t, PEER_HEADS, PEER_TOPK * PEER_TOPK)
        cidx = (i1[..., :, None] * PEER_NKEYS + i2[..., None, :]).reshape(t, PEER_HEADS, PEER_TOPK * PEER_TOPK)
        best, pos = lax.top_k(cand, PEER_TOPK)
        eidx = jnp.take_along_axis(cidx, pos, axis=-1)
        g = jax.nn.softmax(best, axis=-1)
        act = jax.nn.gelu(jnp.einsum('thkd,td->thk', u[eidx], hb).astype(jnp.float32), approximate=False)
        return jnp.einsum('thk,thkd->td', (g * act).astype(hb.dtype), v[eidx])

    return lax.map(one_block, blocks).reshape(b, L, d)


def trunk_layer(x, ctx, c, c_ctx, lp, update_ctx):
    b, L, d = x.shape
    mod = jax.nn.silu(c) @ lp['ada_w'] + lp['ada_b']
    mod_c = jax.nn.silu(c_ctx) @ lp['ada_w'] + lp['ada_b']
    sh1, sc1, g1, sh2, sc2, g2 = jnp.split(mod[:, None, :], 6, axis=-1)
    csh1, csc1, cg1, csh2, csc2, cg2 = jnp.split(mod_c, 6, axis=-1)
    lg = jax.nn.log_sigmoid(lp['ret_decay'].astype(jnp.float32))
    k_scale = RET_DK ** -0.5

    rows = L // GRID_W
    row = jnp.repeat(jnp.arange(rows, dtype=jnp.float32), GRID_W)
    col = jnp.tile(jnp.arange(GRID_W, dtype=jnp.float32), rows)

    hc = modulate(rmsnorm(ctx, lp['norm_mix_g']), csh1, csc1)
    if update_ctx:
        projc = hc @ lp['w_in']
        kv_c = projc[..., OFF_K:OFF_G]
    else:
        kv_c = hc @ lp['w_in'][:, OFF_K:OFF_G]
    kc = heads(kv_c[..., :QK_WIDTH], RET_DK) * k_scale
    vc = heads(kv_c[..., QK_WIDTH:], RET_DV)
    s_f, s_b = context_states(kc, vc, lg)

    h = modulate(rmsnorm(x, lp['norm_mix_g']), sh1, sc1)
    proj = h @ lp['w_in']
    q = axial_rope(heads(proj[..., OFF_Q:OFF_K], RET_DK), row, col)
    k = axial_rope(heads(proj[..., OFF_K:OFF_V], RET_DK), row, col) * k_scale
    v = heads(proj[..., OFF_V:OFF_G], RET_DV)
    y = bidir_retention(q, k, v, lg, s_f, s_b)
    x = x + g1 * mix_tokens(proj, y, lp)

    hf = modulate(rmsnorm(x, lp['norm_ffn_g']), sh2, sc2)
    x = x + g2 * peer_ffn(hf, lp['peer_wq'], lp['peer_keys'], lp['peer_u'], lp['peer_v'])

    if update_ctx:
        qc = heads(projc[..., OFF_Q:OFF_K], RET_DK)
        zero = jnp.zeros_like(s_f)
        yc = bidir_retention(qc, kc, vc, lg, zero, zero)
        ctx = ctx + cg1 * mix_tokens(projc, yc, lp)
        hcf = modulate(rmsnorm(ctx, lp['norm_ffn_g']), csh2, csc2)
        ctx = ctx + cg2 * peer_ffn(hcf, lp['peer_wq'], lp['peer_keys'], lp['peer_u'], lp['peer_v'])
    return x, ctx


def setup_inputs(seed: int = 0) -> dict:
    key = jax.random.key(seed)
    ks = jax.random.split(key, 24)
    f32 = jnp.float32
    D = D_MODEL

    def nrm(k, shape, s):
        return jax.random.normal(k, shape, f32) * s

    base_logit = jnp.log(2.0 ** (5.0 + jnp.arange(RET_HEADS, dtype=f32)) - 1.0)
    return {
        'x': nrm(ks[0], (BATCH, SEQ, D), 1.0),
        'c': nrm(ks[1], (BATCH, D), 1.0),
        'ctx': nrm(ks[2], (BATCH, CTX_LEN, D), 1.0),
        'c_ctx': nrm(ks[3], (D,), 1.0),
        'ada_w': nrm(ks[4], (DEPTH, D, 6 * D), 0.5 * D ** -0.5),
        'ada_b': nrm(ks[5], (DEPTH, 6 * D), 0.02),
        'norm_mix_g': 1.0 + nrm(ks[6], (DEPTH, D), 0.02),
        'norm_ffn_g': 1.0 + nrm(ks[7], (DEPTH, D), 0.02),
        'w_in': nrm(ks[8], (DEPTH, D, IN_WIDTH), D ** -0.5),
        'pool_w': nrm(ks[9], (DEPTH, len(POOL_WINDOWS), POOL_GROUP, POOL_GROUP), POOL_GROUP ** -0.5),
        'pool_scale': 1.0 + nrm(ks[10], (DEPTH, POOL_WIDTH), 0.1),
        'pool_out': nrm(ks[11], (DEPTH, POOL_WIDTH, D), POOL_WIDTH ** -0.5),
        'ret_decay': base_logit[None, None, :] + nrm(ks[12], (DEPTH, 2, RET_HEADS), 0.1),
        'ret_norm_g': 1.0 + nrm(ks[13], (DEPTH, V_WIDTH), 0.02),
        'ret_out': nrm(ks[14], (DEPTH, V_WIDTH, D), V_WIDTH ** -0.5),
        'w_out': nrm(ks[15], (DEPTH, D, D), D ** -0.5),
        'peer_wq': nrm(ks[16], (DEPTH, D, PEER_HEADS * PEER_DQ), D ** -0.5),
        'peer_keys': nrm(ks[17], (DEPTH, PEER_HEADS, 2, PEER_NKEYS, PEER_DQ // 2), (PEER_DQ // 2) ** -0.5),
        'peer_u': nrm(ks[18], (DEPTH, PEER_EXPERTS, D), D ** -0.5),
        'peer_v': nrm(ks[19], (DEPTH, PEER_EXPERTS, D), 0.5),
        'final_g': 1.0 + nrm(ks[20], (D,), 0.02),
    }


def reference(x, c, ctx, c_ctx, ada_w, ada_b, norm_mix_g, norm_ffn_g, w_in, pool_w,
              pool_scale, pool_out, ret_decay, ret_norm_g, ret_out, w_out, peer_wq,
              peer_keys, peer_u, peer_v, final_g):
    for layer in range(DEPTH):
        lp = {
            'ada_w': ada_w[layer], 'ada_b': ada_b[layer],
            'norm_mix_g': norm_mix_g[layer], 'norm_ffn_g': norm_ffn_g[layer],
            'w_in': w_in[layer], 'pool_w': pool_w[layer], 'pool_scale': pool_scale[layer],
            'pool_out': pool_out[layer], 'ret_decay': ret_decay[layer],
            'ret_norm_g': ret_norm_g[layer], 'ret_out': ret_out[layer], 'w_out': w_out[layer],
            'peer_wq': peer_wq[layer], 'peer_keys': peer_keys[layer],
            'peer_u': peer_u[layer], 'peer_v': peer_v[layer],
        }
        x, ctx = trunk_layer(x, ctx, c, c_ctx, lp, layer + 1 < DEPTH)
    return rmsnorm(x, final_g)
```

```cpp
#include <hip/hip_runtime.h>
#include <cstdio>
#include <cstdint>


namespace pg8 {
#define PG8_LAS __attribute__((address_space(3)))
typedef unsigned short bf16_t;
typedef short bf16x8 __attribute__((ext_vector_type(8)));
typedef float f32x4 __attribute__((ext_vector_type(4)));
typedef unsigned u32x4 __attribute__((ext_vector_type(4)));
constexpr int BM = 256, BK = 64, HALF = 128, HTB = HALF * BK * 2  , STAGE_BYTES = 8 * HTB, NXCD = 8, WGM = 8;

__host__ __device__ __forceinline__ int lds_byte(int r, int c) { const int st = (r >> 4) * 2 + (c >> 5), rr = r & 15, cc = c & 31, ob = rr * 64 + cc * 2; return st * 1024 + (ob ^ (((ob >> 9) & 1) << 5)); }
__host__ __device__ __forceinline__ void stage_rc(int b, int& R, int& C) { const int st = b / 1024, sb = b % 1024, swz = sb ^ (((sb >> 9) & 1) << 5); R = (st >> 1) * 16 + swz / 64; C = (st & 1) * 32 + (swz % 64) / 2; }
__host__ __device__ __forceinline__ int perm32(int rho) { const int n = rho >> 4, i = rho & 15; return 8 * (i >> 2) + 4 * n + (i & 3); }

struct Unit { int pm, pn; };
struct Gemm { const bf16_t* A; const bf16_t* Bt; int M, N, K; };

struct StaticOrder {
    int nM, nN, nwg, G, c;
    __host__ __device__ void init(int M, int N, int G_, int c_) { nM = M / BM; nN = N / BM; nwg = nM * nN; G = G_; c = c_; }
    __host__ __device__ bool next(int i, Unit& u) const {
        const long L = (long)i * G + c; if (L >= nwg) return false;
        int wgid = (int)L; { const int q = nwg / NXCD, r = nwg % NXCD, xcd = wgid % NXCD, off = wgid / NXCD; wgid = (xcd < r ? xcd * (q + 1) : r * (q + 1) + (xcd - r) * q) + off; }
        const int nig = WGM * nN, gid = wgid / nig, fm = gid * WGM, gsz = (nM - fm) < WGM ? (nM - fm) : WGM;
        u.pm = fm + ((wgid % nig) % gsz); u.pn = (wgid % nig) / gsz; return true;
    }
    __device__ __forceinline__ void a_ready(const Unit&) const {}
    __device__ __forceinline__ void done(const Unit&) const {}
};
__device__ __forceinline__ unsigned cvt_pk_bf16(float lo, float hi) { unsigned r; asm volatile("v_cvt_pk_bf16_f32 %0, %1, %2" : "=v"(r) : "v"(lo), "v"(hi)); return r; }
typedef int v4i_t __attribute__((ext_vector_type(4))); typedef int v8i_t __attribute__((ext_vector_type(8)));
__device__ __forceinline__ v8i_t cat8(bf16x8 a, bf16x8 b) { const v4i_t x = __builtin_bit_cast(v4i_t, a), y = __builtin_bit_cast(v4i_t, b); return __builtin_shufflevector(x, y, 0, 1, 2, 3, 4, 5, 6, 7); }
template <class Epi, class Sched, bool ALIGN_EPI = false, bool SP2 = false, bool F8 = false>
__device__ __forceinline__ void gemm_phase(PG8_LAS unsigned char* lds, const Gemm g, const Sched& S, const Epi& E, int wave_id) {
    int tid; asm volatile("v_mbcnt_lo_u32_b32 %0, -1, 0\n\tv_mbcnt_hi_u32_b32 %0, -1, %0" : "=v"(tid)); tid += wave_id * 64;
    const int wid = __builtin_amdgcn_readfirstlane(tid >> 6), lane = tid & 63, wr = wid >> 2, wc = wid & 3, fr = lane & 15, fq = lane >> 4;
    const int K = g.K, nt = K / BK;
    unsigned voffA[2], voffB[2];
#pragma unroll
    for (int i = 0; i < 2; ++i) { int R, C; stage_rc(tid * 16 + i * 8192, R, C); const int Rb = Epi::PERM ? ((R & ~31) + perm32(R & 31)) : R;
        voffA[i] = (unsigned)(R * K + C) * 2u; voffB[i] = (unsigned)(Rb * K + C) * 2u; }
    const size_t kstep = (size_t)(BK * 2);
    const size_t hstep = (size_t)HALF * K * 2;
    const size_t tstep = 2 * hstep;
    const unsigned ldsw = (unsigned)wid * 1024u;
    const int aoff = lds_byte(wr * 64 + fr, fq * 8), boff = lds_byte(wc * 32 + fr, fq * 8);
#define PG8_SA(b, h) (((b) * 2 + (h)) * HTB)
#define PG8_SB(b, h) ((4 + (b) * 2 + (h)) * HTB)
#define PG8_STAGE(bufoff, gbase, voff) do { _Pragma("unroll") for (int _i = 0; _i < 2; ++_i) \
        __builtin_amdgcn_global_load_lds((const unsigned*)((const char*)(gbase) + (voff)[_i]), (PG8_LAS unsigned*)(lds + (bufoff) + ldsw + _i * 8192), 16, 0, 0); } while (0)
#define PG8_LDA(dst, b, h) do { _Pragma("unroll") for (int m = 0; m < 4; ++m) _Pragma("unroll") for (int k = 0; k < 2; ++k) dst[m][k] = *(const PG8_LAS bf16x8*)(lds + PG8_SA(b, h) + aoff + m * 2048 + k * 1024); } while (0)
#define PG8_LDB(dst, b, h) do { _Pragma("unroll") for (int n = 0; n < 2; ++n) _Pragma("unroll") for (int k = 0; k < 2; ++k) dst[n][k] = *(const PG8_LAS bf16x8*)(lds + PG8_SB(b, h) + boff + n * 2048 + k * 1024); } while (0)
#define PG8_MMA(ai, bj, At, Bt) do { __builtin_amdgcn_s_setprio(1); _Pragma("unroll") for (int m = 0; m < 4; ++m) _Pragma("unroll") for (int n = 0; n < 2; ++n) { \
        if constexpr (F8) { const v8i_t b8_ = cat8(Bt[n][0], Bt[n][1]), a8_ = cat8(At[m][0], At[m][1]); asm volatile("v_mfma_f32_16x16x128_f8f6f4 %0, %1, %2, %0" : "+v"(acc[ai][bj][m][n]) : "v"(b8_), "v"(a8_)); } \
        else { _Pragma("unroll") for (int k = 0; k < 2; ++k) acc[ai][bj][m][n] = __builtin_amdgcn_mfma_f32_16x16x32_bf16(Bt[n][k], At[m][k], acc[ai][bj][m][n], 0, 0, 0); } } __builtin_amdgcn_s_setprio(0); } while (0)
#define PG8_WAIT_V(n) asm volatile("s_waitcnt vmcnt(" #n ")" ::: "memory")
#define PG8_WAIT_L(n) asm volatile("s_waitcnt lgkmcnt(" #n ")" ::: "memory")
#define PG8_BAR __builtin_amdgcn_s_barrier()
#define PG8_SCHED __builtin_amdgcn_sched_barrier(0)
    Unit cur, nxt; int ui = 0;
    if (!S.next(0, cur)) return;
    f32x4 acc[2][2][4][2];
#pragma unroll
    for (int a = 0; a < 2; ++a)
#pragma unroll
        for (int b = 0; b < 2; ++b)
#pragma unroll
            for (int m = 0; m < 4; ++m)
#pragma unroll
                for (int n = 0; n < 2; ++n) acc[a][b][m][n] = (f32x4){0.f, 0.f, 0.f, 0.f};
    bf16x8 At[4][2], B0[2][2], B1[2][2];
    const char* cA = (const char*)g.A + (size_t)cur.pm * tstep; const char* cB = (const char*)g.Bt + (size_t)cur.pn * tstep;
    S.a_ready(cur);
    if constexpr (SP2) {
        PG8_STAGE(PG8_SB(0, 0), cB, voffB); PG8_STAGE(PG8_SB(0, 1), cB + hstep, voffB); PG8_STAGE(PG8_SA(0, 0), cA, voffA); PG8_STAGE(PG8_SA(0, 1), cA + hstep, voffA);
        if (wr == 1) PG8_BAR;
        PG8_WAIT_V(2); PG8_BAR;
        PG8_STAGE(PG8_SB(1, 0), cB + kstep, voffB); PG8_STAGE(PG8_SA(1, 0), cA + kstep, voffA); PG8_STAGE(PG8_SB(1, 1), cB + hstep + kstep, voffB);
        PG8_WAIT_V(6); PG8_BAR;
    } else {
        PG8_STAGE(PG8_SB(0, 0), cB, voffB); PG8_STAGE(PG8_SA(0, 0), cA, voffA); PG8_STAGE(PG8_SB(0, 1), cB + hstep, voffB); PG8_STAGE(PG8_SA(0, 1), cA + hstep, voffA);
        if (wr == 1) PG8_BAR;
        PG8_WAIT_V(4); PG8_BAR;
        PG8_STAGE(PG8_SB(1, 0), cB + kstep, voffB); PG8_STAGE(PG8_SA(1, 0), cA + kstep, voffA); PG8_STAGE(PG8_SB(1, 1), cB + hstep + kstep, voffB);
        PG8_WAIT_V(6); PG8_BAR;
    }
    for (;;) {
        const bool has_next = S.next(ui + 1, nxt);
        const char* nA = has_next ? (const char*)g.A + (size_t)nxt.pm * tstep : cA; const char* nB = has_next ? (const char*)g.Bt + (size_t)nxt.pn * tstep : cB;
        for (int t = 0; t < nt; t += 2) {
            if (t == E.mid_t) { if constexpr (F8) asm volatile("s_nop 15\n\ts_nop 15" ::: "memory"); E.mid(acc, cur, wr, wc, fr, fq); }
            const bool last = (t == nt - 2);
            const char* a1 = cA + (size_t)(t + 1) * kstep;
            const char* a2 = last ? nA : cA + (size_t)(t + 2) * kstep; const char* b2 = last ? nB : cB + (size_t)(t + 2) * kstep;
            const char* a3 = a2 + kstep; const char* b3 = b2 + kstep;
            if (last && has_next) S.a_ready(nxt);
            if constexpr (SP2) {
            PG8_LDB(B0, 0, 0); PG8_LDB(B1, 0, 1); PG8_SCHED; PG8_LDA(At, 0, 0); PG8_STAGE(PG8_SA(1, 1), a1 + hstep, voffA);
            PG8_WAIT_V(8); PG8_WAIT_L(0); PG8_BAR; PG8_MMA(0, 0, At, B0); PG8_MMA(0, 1, At, B1); PG8_BAR; PG8_SCHED;
            PG8_LDA(At, 0, 1); PG8_STAGE(PG8_SB(0, 0), b2, voffB); PG8_STAGE(PG8_SB(0, 1), b2 + hstep, voffB); PG8_STAGE(PG8_SA(0, 0), a2, voffA);
            PG8_WAIT_V(8); PG8_WAIT_L(0); PG8_BAR; PG8_MMA(1, 0, At, B0); PG8_MMA(1, 1, At, B1); PG8_BAR; PG8_SCHED;
            PG8_LDB(B0, 1, 0); PG8_LDB(B1, 1, 1); PG8_SCHED; PG8_LDA(At, 1, 0); PG8_STAGE(PG8_SA(0, 1), a2 + hstep, voffA);
            PG8_WAIT_V(8); PG8_WAIT_L(0); PG8_BAR; PG8_MMA(0, 0, At, B0); PG8_MMA(0, 1, At, B1); PG8_BAR; PG8_SCHED;
            PG8_LDA(At, 1, 1); PG8_STAGE(PG8_SB(1, 0), b3, voffB); PG8_STAGE(PG8_SB(1, 1), b3 + hstep, voffB); PG8_STAGE(PG8_SA(1, 0), a3, voffA);
            PG8_WAIT_V(8); PG8_WAIT_L(0); PG8_BAR; PG8_MMA(1, 0, At, B0); PG8_MMA(1, 1, At, B1); PG8_BAR; PG8_SCHED;
            } else {
            PG8_LDB(B0, 0, 0); PG8_SCHED; PG8_LDA(At, 0, 0); PG8_STAGE(PG8_SA(1, 1), a1 + hstep, voffA);
            PG8_WAIT_L(8); PG8_BAR; PG8_WAIT_L(0); PG8_MMA(0, 0, At, B0); PG8_BAR; PG8_SCHED;
            PG8_LDB(B1, 0, 1); PG8_STAGE(PG8_SB(0, 0), b2, voffB);
            PG8_BAR; PG8_WAIT_L(0); PG8_MMA(0, 1, At, B1); PG8_BAR;
            PG8_LDA(At, 0, 1); PG8_STAGE(PG8_SA(0, 0), a2, voffA);
            PG8_BAR; PG8_WAIT_L(0); PG8_MMA(1, 0, At, B0); PG8_BAR; PG8_SCHED;
            PG8_STAGE(PG8_SB(0, 1), b2 + hstep, voffB);
            PG8_WAIT_V(6); PG8_BAR; PG8_MMA(1, 1, At, B1); PG8_BAR;
            PG8_LDB(B0, 1, 0); PG8_SCHED; PG8_LDA(At, 1, 0); PG8_STAGE(PG8_SA(0, 1), a2 + hstep, voffA);
            PG8_WAIT_L(8); PG8_BAR; PG8_WAIT_L(0); PG8_MMA(0, 0, At, B0); PG8_BAR; PG8_SCHED;
            PG8_LDB(B1, 1, 1); PG8_STAGE(PG8_SB(1, 0), b3, voffB);
            PG8_BAR; PG8_WAIT_L(0); PG8_MMA(0, 1, At, B1); PG8_BAR;
            PG8_LDA(At, 1, 1); PG8_STAGE(PG8_SA(1, 0), a3, voffA);
            PG8_BAR; PG8_WAIT_L(0); PG8_MMA(1, 0, At, B0); PG8_BAR; PG8_SCHED;
            PG8_STAGE(PG8_SB(1, 1), b3 + hstep, voffB);
            PG8_WAIT_V(6); PG8_BAR; PG8_MMA(1, 1, At, B1); PG8_BAR;
            }
        }
        if constexpr (ALIGN_EPI) { if (wr == 0) PG8_BAR; }
        if constexpr (F8) asm volatile("s_nop 15\n\ts_nop 15" ::: "memory");
        if constexpr (!Epi::AFTER_DRAIN) { E(acc, cur, wr, wc, fr, fq); S.done(cur); }
        if (!has_next) break;
#pragma unroll
        for (int a = 0; a < 2; ++a)
#pragma unroll
            for (int b = 0; b < 2; ++b)
#pragma unroll
                for (int m = 0; m < 4; ++m)
#pragma unroll
                    for (int n = 0; n < 2; ++n) acc[a][b][m][n] = (f32x4){0.f, 0.f, 0.f, 0.f};
        cur = nxt; cA = nA; cB = nB; ++ui;
        if constexpr (ALIGN_EPI) { if (wr == 1) PG8_BAR; }
    }
    PG8_WAIT_V(0);
    if constexpr (!ALIGN_EPI) { if (wr == 0) PG8_BAR; }
    PG8_BAR;
    if constexpr (Epi::AFTER_DRAIN) { E.fused(acc, cur, wr, wc, fr, fq, lds, wid, lane); S.done(cur); }
#undef PG8_SA
#undef PG8_SB
#undef PG8_STAGE
#undef PG8_LDA
#undef PG8_LDB
#undef PG8_MMA
#undef PG8_WAIT_V
#undef PG8_WAIT_L
#undef PG8_BAR
#undef PG8_SCHED
}
}

constexpr int NWAVES = 8;
constexpr int DM = 1024, NB = 32, SEQ = 2048, NT = NB * SEQ;
constexpr int LC = 256, NTC = NB * LC;
constexpr int INW = 5632, NH = 4, DK = 128, DV = 256, CH = 128, NCH = SEQ / CH;
constexpr int PH = 8, PNK = 128, PTOP = 16, PEXP = PNK * PNK;
constexpr float EPS = 1e-6f;
constexpr int NPQ = 1024;
constexpr int NPG = 3584;
constexpr int NPS = 1024;

constexpr size_t MiB = 1u << 20;
constexpr size_t WS_CTL = 0, CTL_ZERO_BYTES = 2 * MiB;
constexpr size_t WS_MOD = 65536;
constexpr size_t WS_COS = 2 * MiB, WS_SIN = WS_COS + 512 * 1024;
constexpr size_t WS_DEC = 4 * MiB;
constexpr size_t WS_WINN = 8 * MiB, WS_WINN8 = 10 * MiB, WS_WINS = 17 * MiB, WS_WPOOL = 20 * MiB, WS_WRET = 21 * MiB, WS_WOUT = 23 * MiB, WS_WEFF = 25 * MiB;
constexpr size_t WS_U = 32 * MiB, WS_V = 64 * MiB;
constexpr size_t WS_P = 96 * MiB, WS_Q = 160 * MiB, WS_K = 224 * MiB, WS_KTF = 288 * MiB, WS_KTB = 352 * MiB;
constexpr size_t WS_KC = 416 * MiB, WS_VTC = 432 * MiB;
constexpr size_t WS_VT = 480 * MiB, WS_G = 608 * MiB, WS_MG = 736 * MiB, WS_END = 1024 * MiB;
constexpr size_t WS_CAT = WS_KTF;
constexpr size_t WS_MERGED = WS_VT, WS_X1 = WS_P, WS_HF = WS_G, WS_SC = WS_MG;
constexpr size_t WS_EIDX = WS_KTB, WS_GATE = WS_KTB + 16 * MiB;
constexpr size_t WS_USCALE = WS_DEC + 16384, WS_VSCALE = WS_USCALE + 65536;
constexpr size_t WS_HQ = 400 * MiB, WS_HSC = 464 * MiB;
constexpr size_t WS_PART = WS_MG, WS_PEERO = WS_MG, WS_WGT = WS_VT;
constexpr size_t DO_H = 0, DO_HC = 128 * MiB, DO_H8 = 160 * MiB, DO_YF = 0, DO_YB = 128 * MiB;

constexpr int CW_TMO = 0, CW_DBG = 2, CW_BAR = 4096;
constexpr int DT_KDF = 0, DT_KDB = 512, DT_QDF = 1024, DT_QDB = 1536, DT_BLKF = 2048, DT_BLKB = 2052, DT_LGF = 2056, DT_LGB = 2060;

constexpr int LDS_BYTES = 155648;
constexpr int LDSCTL_OFF = 151552;

#define GAS __attribute__((address_space(1)))
#define LAS __attribute__((address_space(3)))
typedef unsigned short bf16;
typedef unsigned v4u __attribute__((ext_vector_type(4)));
typedef unsigned v2u __attribute__((ext_vector_type(2)));
typedef float f32x4 __attribute__((ext_vector_type(4)));
typedef float f32x2 __attribute__((ext_vector_type(2)));
typedef short bf16x8 __attribute__((ext_vector_type(8)));
typedef GAS unsigned gu32;
#define RLX_AGENT __ATOMIC_RELAXED, __HIP_MEMORY_SCOPE_AGENT
#define LDS_WAIT() asm volatile("s_waitcnt lgkmcnt(0)" ::: "memory")
#define VM_WAIT() asm volatile("s_waitcnt vmcnt(0)" ::: "memory")
__device__ __forceinline__ unsigned f2bf(float f) { unsigned u = __builtin_bit_cast(unsigned, f); return (u + 0x7fffu + ((u >> 16) & 1u)) >> 16; }
__device__ __forceinline__ unsigned pk2(float lo, float hi) { return f2bf(lo) | (f2bf(hi) << 16); }
__device__ __forceinline__ float bflo(unsigned w) { return __builtin_bit_cast(float, w << 16); }
__device__ __forceinline__ float bfhi(unsigned w) { return __builtin_bit_cast(float, w & 0xffff0000u); }
__device__ __forceinline__ float bf2f(bf16 v) { return __builtin_bit_cast(float, (unsigned)v << 16); }
__device__ __forceinline__ int ixor1(int v) { return __builtin_amdgcn_mov_dpp(v, 0xB1, 0xf, 0xf, true); }
__device__ __forceinline__ int ixor2(int v) { return __builtin_amdgcn_mov_dpp(v, 0x4E, 0xf, 0xf, true); }
__device__ __forceinline__ int ixor4(int v) { int r = __builtin_amdgcn_update_dpp(v, v, 0x104, 0xf, 0x5, false); return __builtin_amdgcn_update_dpp(r, v, 0x114, 0xf, 0xA, false); }
__device__ __forceinline__ int ixor8(int v) { return __builtin_amdgcn_mov_dpp(v, 0x128, 0xf, 0xf, true); }
__device__ __forceinline__ float fxor1(float v) { return __builtin_bit_cast(float, ixor1(__builtin_bit_cast(int, v))); }
__device__ __forceinline__ float fxor2(float v) { return __builtin_bit_cast(float, ixor2(__builtin_bit_cast(int, v))); }
__device__ __forceinline__ float fxor4(float v) { return __builtin_bit_cast(float, ixor4(__builtin_bit_cast(int, v))); }
__device__ __forceinline__ float fxor8(float v) { return __builtin_bit_cast(float, ixor8(__builtin_bit_cast(int, v))); }
__device__ __forceinline__ float red16(float lo, float hi) { asm volatile("v_nop\n\tv_nop\n\tv_permlane16_swap_b32 %0, %1" : "+v"(lo), "+v"(hi)); return lo + hi; }
__device__ __forceinline__ float red32(float lo, float hi) { asm volatile("v_nop\n\tv_nop\n\tv_permlane32_swap_b32 %0, %1" : "+v"(lo), "+v"(hi)); return lo + hi; }
__device__ __forceinline__ float wave_sum(float v) {
    v += fxor1(v); v += fxor2(v); v += fxor4(v); v += fxor8(v); v = red16(v, v); return red32(v, v);
}
__device__ __forceinline__ float sigmoidf_(float v) { return __builtin_amdgcn_rcpf(1.f + __expf(-v)); }
__device__ __forceinline__ f32x4 mfma16(bf16x8 a, bf16x8 b, f32x4 c) { return __builtin_amdgcn_mfma_f32_16x16x32_bf16(a, b, c, 0, 0, 0); }

__device__ __forceinline__ int lane_id() { int l; asm volatile("v_mbcnt_lo_u32_b32 %0, -1, 0\n\tv_mbcnt_hi_u32_b32 %0, -1, %0" : "=v"(l)); return l; }
#define XB_TMO      128
#define XB_XCNT(j)  (256  + 64 * (j))
#define XB_XSUB(j)  (1280 + 64 * (j))
#define XB_XGEN(j)  (2304 + 64 * (j))
#define XB_TOP      3328
#define XB_TOPGEN   3392
#define XCD_BAR_WORDS 3456
#define XB_SPIN_CAP (1u << 22)
__device__ __forceinline__ unsigned xb_ld(unsigned* p)              { return __hip_atomic_load(p, __ATOMIC_RELAXED, __HIP_MEMORY_SCOPE_AGENT); }
__device__ __forceinline__ unsigned xb_add(unsigned* p, unsigned v) { return __hip_atomic_fetch_add(p, v, __ATOMIC_RELAXED, __HIP_MEMORY_SCOPE_AGENT); }
__device__ __forceinline__ unsigned xb_xcc_id() { return (unsigned)__builtin_amdgcn_s_getreg((3 << 11) | 20) & 0xFu; }
#define XB_SPIN(cond, bar) do { unsigned _sp = 0; while (cond) { __builtin_amdgcn_s_sleep(1); \
    if ((++_sp & 255u) == 0u) { if (xb_ld(&(bar)[XB_TMO])) break; if (_sp > XB_SPIN_CAP) { atomicAdd(&(bar)[XB_TMO], 1u); break; } } } } while (0)
struct XcdBarrier { unsigned* bar; unsigned x; volatile LAS unsigned* st; };
__device__ __forceinline__ XcdBarrier xcd_barrier_post(unsigned* bar, volatile LAS unsigned* st) {
    XcdBarrier b; b.bar = bar; b.x = xb_xcc_id(); b.st = st;
    if (threadIdx.x == 0) (void)xb_add(&bar[XB_XCNT(b.x)], 1u);
    return b;
}
__device__ __forceinline__ void xcd_barrier_complete(unsigned* bar, unsigned x, unsigned& nloc, unsigned& nx) {
    const unsigned G = gridDim.x * gridDim.y * gridDim.z;
    unsigned sum, cnt, mine, sp = 0u;
    for (;;) {
        sum = 0u; cnt = 0u; mine = 0u;
#pragma unroll
        for (unsigned j = 0; j < 16; ++j) { const unsigned c = xb_ld(&bar[XB_XCNT(j)]); sum += c; cnt += (c > 0u) ? 1u : 0u; mine = (j == x) ? c : mine; }
        if (sum == G) break;
        __builtin_amdgcn_s_sleep(1);
        if ((++sp & 255u) == 0u) { if (xb_ld(&bar[XB_TMO])) break; if (sp > XB_SPIN_CAP) { atomicAdd(&bar[XB_TMO], 1u); break; } }
    }
    nloc = mine > 0u ? mine : 1u; nx = cnt > 0u ? cnt : 1u;
}
__device__ __forceinline__ void xcd_barrier(const XcdBarrier& b, int wave) {
    asm volatile("s_waitcnt vmcnt(0)" ::: "memory");
    __syncthreads();
    if (wave == 0 && lane_id() == 0) {
        unsigned* bar = b.bar; asm volatile("" : "+s"(bar));
        __builtin_amdgcn_s_waitcnt(0);
        unsigned nloc = b.st[0], nx = b.st[1];
        if (nloc == 0u) { xcd_barrier_complete(bar, b.x, nloc, nx); b.st[0] = nloc; b.st[1] = nx; }
        const unsigned old = xb_add(&bar[XB_XSUB(b.x)], 1u);
        const unsigned gen = old / nloc;
        if (old + 1u == (gen + 1u) * nloc) {
            __builtin_amdgcn_fence(__ATOMIC_RELEASE, "agent");
            asm volatile("s_waitcnt vmcnt(0)" ::: "memory");
            const unsigned og = xb_add(&bar[XB_TOP], 1u);
            const unsigned tg = og / nx;
            if (og + 1u == (tg + 1u) * nx) xb_add(&bar[XB_TOPGEN], 1u);
            else XB_SPIN(xb_ld(&bar[XB_TOPGEN]) == tg, bar);
            __builtin_amdgcn_fence(__ATOMIC_ACQUIRE, "agent");
            xb_add(&bar[XB_XGEN(b.x)], 1u);
            asm volatile("s_waitcnt vmcnt(0)" ::: "memory");
        } else {
            XB_SPIN(xb_ld(&bar[XB_XGEN(b.x)]) == gen, bar);
            __builtin_amdgcn_fence(__ATOMIC_ACQUIRE, "agent");
            asm volatile("s_waitcnt vmcnt(0)" ::: "memory");
        }
    }
    __syncthreads();
}

struct Args {
    const float *x, *c, *ctx, *c_ctx, *ada_w, *ada_b, *norm_mix_g, *norm_ffn_g, *w_in, *pool_w, *pool_scale, *pool_out, *ret_decay, *ret_norm_g, *ret_out, *w_out,
                *peer_wq, *peer_keys, *peer_u, *peer_v, *final_g;
    float* out; unsigned char* ws;
};

enum { EM_PROJN = 0, EM_PROJS = 1, EM_PROJG = 2, EM_MERGE = 3, EM_OUT = 5, EM_SCORE = 6 };
constexpr float WSC8 = 32.f, ASC8 = 4.f;
__device__ __forceinline__ v4u pack8(f32x4 a, f32x4 b) {
    v4u w; w.x = pg8::cvt_pk_bf16(a[0], a[1]); w.y = pg8::cvt_pk_bf16(a[2], a[3]); w.z = pg8::cvt_pk_bf16(b[0], b[1]); w.w = pg8::cvt_pk_bf16(b[2], b[3]); return w;
}
struct EpiAll {
    static constexpr bool PERM = true, AFTER_DRAIN = false;
    int mode, mid_t; const float* x; float* outf; unsigned char* ws;
    __device__ __forceinline__ void mid(f32x4 (&acc)[2][2][4][2], const pg8::Unit& u, int wr, int wc, int fr, int fq) const {
        asm volatile("" : "+v"(fr), "+v"(fq));
        const int row0 = u.pm * 256 + wr * 64 + fr, colt = u.pn * 256, c0 = wc * 32 + 8 * fq; const unsigned char* mg = ws + WS_MG;
#pragma unroll
        for (int ai = 0; ai < 2; ++ai)
#pragma unroll
            for (int m = 0; m < 4; ++m) { const size_t row = (size_t)(row0 + ai * 128 + m * 16);
#pragma unroll
                for (int bj = 0; bj < 2; ++bj) { const int col = colt + bj * 128 + c0; const v2u gp = *(const v2u*)(mg + row * 2048 + col), gr = *(const v2u*)(mg + row * 2048 + 1024 + col);
#pragma unroll
                    for (int j = 0; j < 4; ++j) { const unsigned r0 = (gr.x >> (8 * j)) & 255u, r1 = (gr.y >> (8 * j)) & 255u;
                        acc[ai][bj][m][0][j] *= (float)((gp.x >> (8 * j)) & 255u) * __builtin_amdgcn_rcpf((float)(r0 ? r0 : 1u)); acc[ai][bj][m][1][j] *= (float)((gp.y >> (8 * j)) & 255u) * __builtin_amdgcn_rcpf((float)(r1 ? r1 : 1u)); } } }
    }
    __device__ __forceinline__ void operator()(const f32x4 (&acc)[2][2][4][2], const pg8::Unit& u, int wr, int wc, int fr, int fq) const {
        asm volatile("" : "+v"(fr), "+v"(fq));
        const int row0 = u.pm * 256 + wr * 64 + fr, colt = u.pn * 256, c0 = wc * 32 + 8 * fq;
        if (mode == EM_PROJG) {
            {
                GAS bf16* dst; int ld, cb, act;
                if (colt < 512) { dst = (GAS bf16*)(ws + WS_P); ld = 512; cb = colt; act = 0; }
                else if (colt < 1536) { dst = (GAS bf16*)(ws + WS_G); ld = 1024; cb = colt - 512; act = 1; }
                else { dst = (GAS bf16*)(ws + WS_MG); ld = 1024; cb = (colt - 1536) >> 1; act = 2; }
#pragma unroll
                for (int ai = 0; ai < 2; ++ai)
#pragma unroll
                    for (int m = 0; m < 4; ++m) { GAS bf16* rowp = dst + (size_t)(row0 + ai * 128 + m * 16) * ld + cb + c0;
#pragma unroll
                        for (int bj = 0; bj < 2; ++bj) { f32x4 v0 = acc[ai][bj][m][0] * (1.f / WSC8), v1 = acc[ai][bj][m][1] * (1.f / WSC8);
                            if (act) {
#pragma unroll
                                for (int j = 0; j < 4; ++j) { const float s0 = sigmoidf_(v0[j]), s1 = sigmoidf_(v1[j]); v0[j] = act == 1 ? v0[j] * s0 : s0; v1[j] = act == 1 ? v1[j] * s1 : s1; } }
                            if (act == 2) { const f32x4 q0 = v0 * 255.f, q1 = v1 * 255.f;
                                v2u o; o.x = 0u; o.y = 0u;
                                o.x = __builtin_amdgcn_cvt_pk_u8_f32(q0[0], 0, o.x); o.x = __builtin_amdgcn_cvt_pk_u8_f32(q0[1], 1, o.x); o.x = __builtin_amdgcn_cvt_pk_u8_f32(q0[2], 2, o.x); o.x = __builtin_amdgcn_cvt_pk_u8_f32(q0[3], 3, o.x);
                                o.y = __builtin_amdgcn_cvt_pk_u8_f32(q1[0], 0, o.y); o.y = __builtin_amdgcn_cvt_pk_u8_f32(q1[1], 1, o.y); o.y = __builtin_amdgcn_cvt_pk_u8_f32(q1[2], 2, o.y); o.y = __builtin_amdgcn_cvt_pk_u8_f32(q1[3], 3, o.y);
                                *(GAS v2u*)((GAS unsigned char*)(dst + (size_t)(row0 + ai * 128 + m * 16) * ld) + (colt - 1536) + bj * 128 + c0) = o; }
                            else *(GAS v4u*)(rowp + bj * 128) = pack8(v0, v1); } }
            }
        } else if (mode == EM_PROJN) {
            {
                const bool isk = colt >= 512, cxr = u.pm * 256 >= NT; const int hb = (colt - (isk ? 512 : 0)) >> 7; const float sc = isk ? 0.08838834764831845f : 1.f;
                if (cxr && !isk) return;
                bf16* dst = (bf16*)(ws + (cxr ? WS_KC : (isk ? WS_K : WS_Q))); const float* cosT = (const float*)(ws + WS_COS); const float* sinT = (const float*)(ws + WS_SIN);
                const int i0 = c0 >> 1;
#pragma unroll
                for (int ai = 0; ai < 2; ++ai)
#pragma unroll
                    for (int m = 0; m < 4; ++m) { const int row = row0 + ai * 128 + m * 16, rr = cxr ? row - NT : row, b = cxr ? rr >> 8 : rr >> 11, l = cxr ? rr & 255 : rr & 2047, LQ = cxr ? 256 : 2048;
                        f32x4 cs = (f32x4){1.f, 1.f, 1.f, 1.f}, sn = (f32x4){0.f, 0.f, 0.f, 0.f}; if (!cxr) { cs = *(const f32x4*)(cosT + l * 64 + i0); sn = *(const f32x4*)(sinT + l * 64 + i0); }
#pragma unroll
                        for (int bj = 0; bj < 2; ++bj) { const f32x4 v0 = acc[ai][bj][m][0], v1 = acc[ai][bj][m][1]; f32x4 o0, o1;
                            o0[0] = (v0[0] * cs[0] - v0[1] * sn[0]) * sc; o0[1] = (v0[0] * sn[0] + v0[1] * cs[0]) * sc;
                            o0[2] = (v0[2] * cs[1] - v0[3] * sn[1]) * sc; o0[3] = (v0[2] * sn[1] + v0[3] * cs[1]) * sc;
                            o1[0] = (v1[0] * cs[2] - v1[1] * sn[2]) * sc; o1[1] = (v1[0] * sn[2] + v1[1] * cs[2]) * sc;
                            o1[2] = (v1[2] * cs[3] - v1[3] * sn[3]) * sc; o1[3] = (v1[2] * sn[3] + v1[3] * cs[3]) * sc;
                            *(v4u*)(dst + ((size_t)((b * 4 + hb + bj) * LQ + l)) * 128 + c0) = pack8(o0, o1); } }
            }
        } else if (mode == EM_PROJS) {
            const bool cx = colt >= NT; const int LL = cx ? 256 : 2048, lsh = cx ? 8 : 11;
            {
                bf16* vt = (bf16*)(ws + (cx ? WS_VTC : WS_VT));
#pragma unroll
                for (int bj = 0; bj < 2; ++bj) { const int t0 = (cx ? colt - NT : colt) + bj * 128 + c0, b = t0 >> lsh, l0 = t0 & (LL - 1);
#pragma unroll
                    for (int ai = 0; ai < 2; ++ai)
#pragma unroll
                        for (int m = 0; m < 4; ++m) { const int chn = u.pm * 256 + ai * 128 + wr * 64 + m * 16 + fr, h = chn >> 8, dv = chn & 255;
                            *(v4u*)(vt + (((size_t)(b * 4 + h) * (LL >> 7) + (l0 >> 7)) * 256 + dv) * 128 + (l0 & 127)) = pack8(acc[ai][bj][m][0], acc[ai][bj][m][1]); } }
            }
        } else if (mode == EM_MERGE) {
            const unsigned char* mg = ws + WS_MG + 1024; bf16* mer = (bf16*)(ws + WS_MERGED);
#pragma unroll
            for (int ai = 0; ai < 2; ++ai)
#pragma unroll
                for (int m = 0; m < 4; ++m) { const size_t row = (size_t)(row0 + ai * 128 + m * 16);
#pragma unroll
                    for (int bj = 0; bj < 2; ++bj) { const int col = colt + bj * 128 + c0;
                        const v2u gw = *(const v2u*)(mg + row * 2048 + col); f32x4 v0 = acc[ai][bj][m][0] * (1.f / (WSC8 * ASC8 * 255.f)), v1 = acc[ai][bj][m][1] * (1.f / (WSC8 * ASC8 * 255.f));
#pragma unroll
                        for (int j = 0; j < 4; ++j) { const unsigned r0 = (gw.x >> (8 * j)) & 255u, r1 = (gw.y >> (8 * j)) & 255u; v0[j] *= (float)(r0 ? r0 : 1u); v1[j] *= (float)(r1 ? r1 : 1u); }
                        *(v4u*)(mer + row * 1024 + col) = pack8(v0, v1); } }
        } else if (mode == EM_OUT) {
            const float* mod = (const float*)(ws + WS_MOD); bf16* x1 = (bf16*)(ws + WS_X1);
#pragma unroll
            for (int bj = 0; bj < 2; ++bj) { const int col = colt + bj * 128 + c0, b = row0 >> 11;
                const f32x4 g0 = *(const f32x4*)(mod + b * 6144 + 2048 + col), g1 = *(const f32x4*)(mod + b * 6144 + 2048 + col + 4);
#pragma unroll
                for (int ai = 0; ai < 2; ++ai)
#pragma unroll
                    for (int m = 0; m < 4; ++m) { const int row = row0 + ai * 128 + m * 16; const size_t o = (size_t)row * 1024 + col;
                        const f32x4 x0 = *(const f32x4*)(x + o), xb = *(const f32x4*)(x + o + 4);
                        *(v4u*)(x1 + o) = pack8(x0 + g0 * acc[ai][bj][m][0], xb + g1 * acc[ai][bj][m][1]); } }
        } else {
            bf16* sc = (bf16*)(ws + WS_SC);
#pragma unroll
            for (int ai = 0; ai < 2; ++ai)
#pragma unroll
                for (int m = 0; m < 4; ++m) { bf16* rowp = sc + (size_t)(row0 + ai * 128 + m * 16) * 2048 + colt + c0;
#pragma unroll
                    for (int bj = 0; bj < 2; ++bj) *(v4u*)(rowp + bj * 128) = pack8(acc[ai][bj][m][0], acc[ai][bj][m][1]); }
        }
    }
};

struct Ctx { LAS unsigned char* lds; int tid, lane, wave, vcu, G; };
__device__ __forceinline__ Ctx fresh(const Ctx& F0) {
    Ctx F; F.lds = F0.lds; int t = F0.wave * 64 + lane_id(); asm volatile("" : "+v"(t)); F.tid = t; F.lane = t & 63; F.wave = __builtin_amdgcn_readfirstlane(t >> 6);
    F.G = (int)gridDim.x; const int bx = (int)blockIdx.x; F.vcu = (F.G % 8 == 0) ? (bx % 8) * (F.G / 8) + bx / 8 : bx; return F; }
#define CAS __attribute__((address_space(4)))
__device__ __forceinline__ Args fresh(const Args& a0) {
#if defined(__HIP_DEVICE_COMPILE__)
    const CAS unsigned long long* kp = (const CAS unsigned long long*)__builtin_amdgcn_kernarg_segment_ptr(); asm volatile("" : "+s"(kp));
    Args a; unsigned long long* dst = (unsigned long long*)&a;
#pragma unroll
    for (int i = 0; i < (int)(sizeof(Args) / 8); ++i) dst[i] = kp[i];
    return a;
#else
    return a0;
#endif
}

__device__ __forceinline__ int mapN(int r) {
    const int sec = r < 512 ? 512 : 1024, q = r & 511, hh = q >> 7, p = q & 127; return sec + hh * 128 + (p & 1) * 64 + (p >> 1);
}
__device__ __forceinline__ int mapG(int r) {
    if (r < 512) return r;
    if (r < 1536) return 2560 + (r - 512);
    return 3584 + (r - 1536);
}
__device__ __forceinline__ int mapS(int r) {
    return 1536 + r;
}
template <int MAP, bool OUT8> __device__ __forceinline__ void p0_transpose_item(const float* W, int ldw, int K, int nrows, const float* kscale, void* WTv, LAS float* scr, int item, int lane, int ldo = 0) {
    const int nblk = nrows / 32, kb = item / nblk, nb = item % nblk, k0 = 64 * kb, n0 = 32 * nb;
    const int rr = n0 + (lane & 31); const int sc = MAP == 1 ? mapN(rr) : (MAP == 2 ? mapS(rr) : (MAP == 3 ? mapG(rr) : rr));
#pragma unroll 8
    for (int i = 0; i < 32; ++i) { const int kk = 2 * i + (lane >> 5); float v = W[(size_t)(k0 + kk) * ldw + sc]; if (kscale) v *= kscale[k0 + kk]; scr[kk * 33 + (lane & 31)] = v; }
    LDS_WAIT(); asm volatile("" ::: "memory");
    const int c = lane & 7;
#pragma unroll
    for (int j = 0; j < 4; ++j) { const int n = (lane >> 3) + 8 * j; const LAS float* s = scr + (8 * c) * 33 + n;
        if (OUT8) { unsigned w0 = 0, w1 = 0;
            w0 = __builtin_amdgcn_cvt_pk_fp8_f32(s[0 * 33] * WSC8, s[1 * 33] * WSC8, w0, false); w0 = __builtin_amdgcn_cvt_pk_fp8_f32(s[2 * 33] * WSC8, s[3 * 33] * WSC8, w0, true);
            w1 = __builtin_amdgcn_cvt_pk_fp8_f32(s[4 * 33] * WSC8, s[5 * 33] * WSC8, w1, false); w1 = __builtin_amdgcn_cvt_pk_fp8_f32(s[6 * 33] * WSC8, s[7 * 33] * WSC8, w1, true);
            *(GAS v2u*)((unsigned char*)WTv + (size_t)(n0 + n) * (ldo ? ldo : K) + k0 + 8 * c) = (v2u){w0, w1}; }
        else { v4u o; o.x = pk2(s[0 * 33], s[1 * 33]); o.y = pk2(s[2 * 33], s[3 * 33]); o.z = pk2(s[4 * 33], s[5 * 33]); o.w = pk2(s[6 * 33], s[7 * 33]);
            *(GAS v4u*)((bf16*)WTv + (size_t)(n0 + n) * K + k0 + 8 * c) = o; } }
    LDS_WAIT(); asm volatile("" ::: "memory");
}

__device__ __forceinline__ void p0_prep(const Args& a0, const Ctx& F0) {
    const Ctx F = fresh(F0); const Args a = fresh(a0);
    unsigned char* ws = a.ws;
    {
        LAS float* s = (LAS float*)F.lds;
        float* mod = (float*)(ws + WS_MOD);
        for (int it = blockIdx.x; it < 256; it += F.G) {
            const int cl = F.tid % 24, kq = F.tid / 24, n = it * 24 + cl, k0 = kq * 64;
            __syncthreads();
            for (int e = F.tid; e < 33 * 1024; e += 512) { const int r = e >> 10, kk = e & 1023; const float v = r < 32 ? a.c[r * 1024 + kk] : a.c_ctx[kk]; s[e] = v * __builtin_amdgcn_rcpf(1.f + __expf(-v)); }
            __syncthreads();
            float acc[33];
#pragma unroll
            for (int r = 0; r < 33; ++r) acc[r] = 0.f;
            if (kq < 16)
                for (int kk = 0; kk < 64; kk += 4) {
                    const float w0 = a.ada_w[(size_t)(k0 + kk) * 6144 + n], w1 = a.ada_w[(size_t)(k0 + kk + 1) * 6144 + n], w2 = a.ada_w[(size_t)(k0 + kk + 2) * 6144 + n], w3 = a.ada_w[(size_t)(k0 + kk + 3) * 6144 + n];
#pragma unroll
                    for (int r = 0; r < 33; ++r) { const f32x4 sv = *(const LAS f32x4*)(s + r * 1024 + k0 + kk); acc[r] += sv[0] * w0 + sv[1] * w1 + sv[2] * w2 + sv[3] * w3; }
                }
            __syncthreads();
            if (kq < 16) {
#pragma unroll
                for (int r = 0; r < 33; ++r) s[(kq * 33 + r) * 24 + cl] = acc[r]; }
            __syncthreads();
            for (int e = F.tid; e < 33 * 24; e += 512) { const int r = e / 24, c = e % 24; float t = 0.f;
#pragma unroll
                for (int q = 0; q < 16; ++q) t += s[(q * 33 + r) * 24 + c];
                mod[r * 6144 + it * 24 + c] = t + a.ada_b[it * 24 + c]; }
        }
        __syncthreads();
    }
    {
        LAS float* kl = (LAS float*)F.lds;
        LAS float* wl = kl + 128 * 133;
        bf16* weff = (bf16*)(ws + WS_WEFF);
        for (int it = blockIdx.x; it < 256; it += F.G) {
            const int hp = it >> 4, kb = it & 15;
            __syncthreads();
            for (int e = F.tid; e < 128 * 128; e += 512) { const int r = e >> 7, d = e & 127; kl[r * 133 + d] = a.peer_keys[(size_t)hp * 16384 + e]; }
            for (int e = F.tid; e < 64 * 128; e += 512) { const int r = e >> 7, d = e & 127; wl[r * 133 + d] = a.peer_wq[(size_t)(kb * 64 + r) * 2048 + hp * 128 + d]; }
            __syncthreads();
            const int kq = F.tid & 15, keyq = F.tid >> 4;
            float acc[4][4];
#pragma unroll
            for (int i = 0; i < 4; ++i)
#pragma unroll
                for (int j = 0; j < 4; ++j) acc[i][j] = 0.f;
            for (int d = 0; d < 128; ++d) {
                float kv[4], wv[4];
#pragma unroll
                for (int i = 0; i < 4; ++i) { kv[i] = kl[(4 * keyq + i) * 133 + d]; wv[i] = wl[(4 * kq + i) * 133 + d]; }
#pragma unroll
                for (int i = 0; i < 4; ++i)
#pragma unroll
                    for (int j = 0; j < 4; ++j) acc[i][j] += kv[i] * wv[j];
            }
#pragma unroll
            for (int i = 0; i < 4; ++i) { v2u o; o.x = pk2(acc[i][0], acc[i][1]); o.y = pk2(acc[i][2], acc[i][3]);
                *(GAS v2u*)(weff + (size_t)(hp * 128 + 4 * keyq + i) * 1024 + kb * 64 + 4 * kq) = o; }
        }
        __syncthreads();
    }
    {
        unsigned char* wp = ws + WS_WPOOL;
        for (int it = blockIdx.x; it < 128; it += F.G) {
            const int k8 = (it >> 1) * 8, n = (it & 1) * 512 + F.tid, g = k8 >> 7;
            float acc[8];
#pragma unroll
            for (int j = 0; j < 8; ++j) acc[j] = 0.f;
            for (int d0 = 0; d0 < 128; d0 += 16) {
                float po[16];
#pragma unroll
                for (int u = 0; u < 16; ++u) po[u] = a.pool_scale[g * 128 + d0 + u] * a.pool_out[(size_t)(g * 128 + d0 + u) * 1024 + n];
#pragma unroll
                for (int j = 0; j < 8; ++j)
#pragma unroll
                    for (int u = 0; u < 16; ++u) acc[j] += a.pool_w[(size_t)(k8 + j) * 128 + d0 + u] * po[u]; }
            unsigned w0 = 0, w1 = 0;
            w0 = __builtin_amdgcn_cvt_pk_fp8_f32(acc[0] * WSC8, acc[1] * WSC8, w0, false); w0 = __builtin_amdgcn_cvt_pk_fp8_f32(acc[2] * WSC8, acc[3] * WSC8, w0, true);
            w1 = __builtin_amdgcn_cvt_pk_fp8_f32(acc[4] * WSC8, acc[5] * WSC8, w1, false); w1 = __builtin_amdgcn_cvt_pk_fp8_f32(acc[6] * WSC8, acc[7] * WSC8, w1, true);
            *(v2u*)(wp + (size_t)n * 1536 + k8) = (v2u){w0, w1};
        }
    }
    {
        LAS float* scr = (LAS float*)(F.lds + F.wave * 8448);
        const int gw = F.vcu * NWAVES + F.wave, NGW = F.G * NWAVES;
        constexpr int I_N = (DM / 64) * (NPQ / 32), I_G = (DM / 64) * (NPG / 32), I_S = (DM / 64) * (NPS / 32), I_R = (DM / 64) * (DM / 32), I_O = I_R;
        for (int it = gw; it < I_N + I_G + I_S + I_R + I_O; it += NGW) {
            int r = it;
            if (r < I_N) { p0_transpose_item<1, false>(a.w_in, INW, DM, NPQ, nullptr, ws + WS_WINN, scr, r, F.lane); continue; } r -= I_N;
            if (r < I_G) { p0_transpose_item<3, true>(a.w_in, INW, DM, NPG, nullptr, ws + WS_WINN8, scr, r, F.lane); continue; } r -= I_G;
            if (r < I_S) { p0_transpose_item<2, false>(a.w_in, INW, DM, NPS, nullptr, ws + WS_WINS, scr, r, F.lane); continue; } r -= I_S;
            if (r < I_R) { p0_transpose_item<0, true>(a.ret_out, DM, DM, DM, a.ret_norm_g, ws + WS_WPOOL + 512, scr, r, F.lane, 1536); continue; } r -= I_R;
            p0_transpose_item<0, false>(a.w_out, DM, DM, DM, nullptr, ws + WS_WOUT, scr, r, F.lane);
        }
        const int gt = (blockIdx.x * 512 + F.tid), NGT = F.G * 512;
        float* cosT = (float*)(ws + WS_COS); float* sinT = (float*)(ws + WS_SIN);
        for (int e = gt; e < SEQ * 64; e += NGT) { const int l = e >> 6, i = e & 63; const float pos = (float)(i < 32 ? (l >> 6) : (l & 63));
            const float inv = exp2f(-(float)(i & 31) * (13.287712379549449f / 32.f)); float sv, cv; sincosf(pos * inv, &sv, &cv);
            cosT[e] = cv; sinT[e] = sv; }
        float* dec = (float*)(ws + WS_DEC);
        for (int e = gt; e < 512; e += NGT) { const int h = e >> 7, j = e & 127;
            const float xf = a.ret_decay[h], xb = a.ret_decay[4 + h]; const float lgf = -log1pf(expf(-xf)), lgb = -log1pf(expf(-xb));
            dec[DT_KDF + e] = expf(lgf * (float)(127 - j)); dec[DT_KDB + e] = expf(lgb * (float)j);
            dec[DT_QDF + e] = expf(lgf * (float)(j + 1)); dec[DT_QDB + e] = expf(lgb * (float)(128 - j));
            if (j == 0) { dec[DT_BLKF + h] = expf(lgf * 128.f); dec[DT_BLKB + h] = expf(lgb * 128.f); dec[DT_LGF + h] = lgf; dec[DT_LGB + h] = lgb; } }
        { GAS unsigned short* dv = (GAS unsigned short*)(ws + WS_V); GAS float* vsc = (GAS float*)(ws + WS_VSCALE); GAS unsigned short* du = (GAS unsigned short*)(ws + WS_U); GAS float* usc = (GAS float*)(ws + WS_USCALE);
          f32x4 nv[4], nu[4];
          if (gw < PEXP) {
#pragma unroll
              for (int j = 0; j < 4; ++j) { nv[j] = ((const GAS f32x4*)(a.peer_v + (size_t)gw * DM) + F.lane)[64 * j]; nu[j] = ((const GAS f32x4*)(a.peer_u + (size_t)gw * DM) + F.lane)[64 * j]; } }
          for (int row = gw; row < PEXP; row += NGW) { f32x4 v[4], u[4]; float m = 0.f, mu = 0.f;
#pragma unroll
              for (int j = 0; j < 4; ++j) { v[j] = nv[j]; u[j] = nu[j]; }
              { const int nr = row + NGW < PEXP ? row + NGW : row;
#pragma unroll
                for (int j = 0; j < 4; ++j) { nv[j] = ((const GAS f32x4*)(a.peer_v + (size_t)nr * DM) + F.lane)[64 * j]; nu[j] = ((const GAS f32x4*)(a.peer_u + (size_t)nr * DM) + F.lane)[64 * j]; } }
              __builtin_amdgcn_sched_barrier(0);
#pragma unroll
              for (int j = 0; j < 4; ++j) { m += (v[j][0] * v[j][0] + v[j][1] * v[j][1]) + (v[j][2] * v[j][2] + v[j][3] * v[j][3]); mu += (u[j][0] * u[j][0] + u[j][1] * u[j][1]) + (u[j][2] * u[j][2] + u[j][3] * u[j][3]); }
              m = wave_sum(m); mu = wave_sum(mu);
              const float sc = m > 0.f ? 0.5f * sqrtf(m * (1.f / DM)) : 1.f, inv = 1.f / sc, scu = mu > 0.f ? 0.35f * sqrtf(mu * (1.f / DM)) : 1.f, invu = 1.f / scu;
              if (F.lane == 0) { vsc[row] = sc; usc[row] = scu; }
#pragma unroll
              for (int j = 0; j < 4; ++j) { unsigned h = 0, hu = 0;
#pragma unroll
                  for (int i = 0; i < 4; ++i) { const float y = v[j][i] * inv, ay = fabsf(y);
                      const unsigned code = (unsigned)(ay > 0.25f) + (unsigned)(ay > 0.75f) + (unsigned)(ay > 1.25f) + (unsigned)(ay > 1.75f) + (unsigned)(ay > 2.5f) + (unsigned)(ay > 3.5f) + (unsigned)(ay > 5.f);
                      h |= (code | (y < 0.f ? 8u : 0u)) << (4 * i);
                      const int q = (int)fminf(fmaxf(rintf(u[j][i] * invu), -7.f), 7.f); hu |= (unsigned)(q & 15) << (4 * i); }
                  dv[((size_t)(j * PEXP + row)) * 64 + F.lane] = (unsigned short)h; du[((size_t)(j * PEXP + row)) * 64 + F.lane] = (unsigned short)hu; } } }
    }
}

__device__ __forceinline__ void norm_row2(const GAS float* x0, const GAS float* x1, const GAS float* g, const GAS float* sh0, const GAS float* sc0, const GAS float* sh1, const GAS float* sc1,
                                          GAS bf16* o0, GAS bf16* o1, GAS unsigned* q0, GAS unsigned* q1, int lane) {
    const GAS f32x4* xr0 = (const GAS f32x4*)x0 + lane; const GAS f32x4* xr1 = (const GAS f32x4*)x1 + lane;
    f32x4 v[4], u[4]; float s = 0.f, t = 0.f;
#pragma unroll
    for (int j = 0; j < 4; ++j) { v[j] = xr0[64 * j]; u[j] = xr1[64 * j]; }
#pragma unroll
    for (int j = 0; j < 4; ++j) { s += (v[j][0] * v[j][0] + v[j][1] * v[j][1]) + (v[j][2] * v[j][2] + v[j][3] * v[j][3]); t += (u[j][0] * u[j][0] + u[j][1] * u[j][1]) + (u[j][2] * u[j][2] + u[j][3] * u[j][3]); }
    const float rs = __builtin_amdgcn_rsqf(wave_sum(s) * (1.f / DM) + EPS), rt = __builtin_amdgcn_rsqf(wave_sum(t) * (1.f / DM) + EPS);
    GAS v2u* p0 = (GAS v2u*)o0 + lane; GAS v2u* p1 = (GAS v2u*)o1 + lane;
#pragma unroll
    for (int j = 0; j < 4; ++j) { const int k = 4 * lane + 256 * j; const f32x4 gg = *(const GAS f32x4*)(g + k);
        const f32x4 m0 = gg * (*(const GAS f32x4*)(sc0 + k) + 1.f), a0 = *(const GAS f32x4*)(sh0 + k);
        const f32x4 y0 = v[j] * rs * m0 + a0; v2u o; o.x = pk2(y0[0], y0[1]); o.y = pk2(y0[2], y0[3]); p0[64 * j] = o;
        const f32x4 y1 = u[j] * rt * m0 + a0; o.x = pk2(y1[0], y1[1]); o.y = pk2(y1[2], y1[3]); p1[64 * j] = o;
        if (q0) { unsigned w = 0; w = __builtin_amdgcn_cvt_pk_fp8_f32(y0[0], y0[1], w, false); w = __builtin_amdgcn_cvt_pk_fp8_f32(y0[2], y0[3], w, true); q0[lane + 64 * j] = w;
            w = __builtin_amdgcn_cvt_pk_fp8_f32(y1[0], y1[1], w, false); w = __builtin_amdgcn_cvt_pk_fp8_f32(y1[2], y1[3], w, true); q1[lane + 64 * j] = w; } }
}
__device__ __forceinline__ void p1_norm(const Args& a0, const Ctx& F0) {
    const Ctx F = fresh(F0); const Args a = fresh(a0);
    const GAS float* mod = (const GAS float*)(a.ws + WS_MOD);
    GAS bf16* H = (GAS bf16*)((GAS unsigned char*)a.out + DO_H);
    const int gw = F.vcu * NWAVES + F.wave, NGW = F.G * NWAVES;
    for (int m = 2 * gw; m < NT + NTC; m += 2 * NGW) {
        const GAS float* xs = m < NT ? (const GAS float*)a.x + (size_t)m * DM : (const GAS float*)a.ctx + (size_t)(m - NT) * DM;
        const GAS float* md = mod + (m < NT ? (m >> 11) : 32) * 6144;
        GAS unsigned* h8 = m < NT ? (GAS unsigned*)((GAS unsigned char*)a.out + DO_H8) + (size_t)m * (DM / 4) : nullptr;
        norm_row2(xs, xs + DM, (const GAS float*)a.norm_mix_g, md, md + 1024, md, md + 1024, H + (size_t)m * DM, H + (size_t)(m + 1) * DM, h8, h8 ? h8 + DM / 4 : nullptr, F.lane);
    }
}

#define LBAR() do { asm volatile("s_waitcnt lgkmcnt(0)" ::: "memory"); __builtin_amdgcn_s_barrier(); asm volatile("" ::: "memory"); } while (0)
typedef short s16x4 __attribute__((ext_vector_type(4)));
constexpr int LROW = 272;
__device__ __forceinline__ void p3_scan(const Args& a0, const Ctx& F0) {
    const Ctx F = fresh(F0); const Args a = fresh(a0);
    GAS unsigned char* ws = (GAS unsigned char*)a.ws; const GAS float* dec = (const GAS float*)(ws + WS_DEC);
    LAS unsigned char* ktl = F.lds; LAS unsigned char* stl = F.lds + 128 * LROW;
    const int w = F.wave, fr = F.lane & 15, fq = F.lane >> 4;
    for (int it = blockIdx.x; it < NB * NH * 2; it += F.G) {
        const int b = it >> 3, h = (it >> 1) & 3, dir = it & 1, bh = b * 4 + h;
        GAS bf16* Y = (GAS bf16*)((GAS unsigned char*)a.out + (dir ? DO_YB : DO_YF));
        f32x4 S[8][2];
#pragma unroll
        for (int t = 0; t < 8; ++t) { S[t][0] = (f32x4){0.f, 0.f, 0.f, 0.f}; S[t][1] = S[t][0]; }
        const float blk = dec[(dir ? DT_BLKB : DT_BLKF) + h];
        v4u kreg[4]; bf16x8 vf[2][4], qf[4];
#pragma unroll
        for (int ks = 0; ks < 4; ++ks) qf[ks] = (bf16x8){0, 0, 0, 0, 0, 0, 0, 0};
#define P3_CC(st_) (dir == 0 ? ((st_) < 2 ? (st_) : (st_) - 2) : ((st_) < 2 ? 1 - (st_) : 17 - (st_)))
#define P3_LOADK(st_) do { const int s_ = (st_); const bool cx_ = s_ < 2; const int LL_ = cx_ ? LC : SEQ; \
            const GAS bf16* src_ = (const GAS bf16*)(ws + (cx_ ? WS_KC : WS_K)) + ((size_t)bh * LL_ + P3_CC(s_) * 128) * 128 + 8 * F.tid;        \
            _Pragma("unroll") for (int j = 0; j < 4; ++j) kreg[j] = *(const GAS v4u*)(src_ + 4096 * j); } while (0)
#define P3_LOADV(st_) do { const int s_ = (st_); const bool cx_ = s_ < 2; const int LL_ = cx_ ? LC : SEQ; \
            const GAS bf16* vt_ = (const GAS bf16*)(ws + (cx_ ? WS_VTC : WS_VT)) + (((size_t)bh * (LL_ >> 7) + P3_CC(s_)) * 256 + 32 * w + fr) * 128 + 8 * fq; \
            _Pragma("unroll") for (int c = 0; c < 2; ++c) _Pragma("unroll") for (int ks = 0; ks < 4; ++ks) vf[c][ks] = *(const GAS bf16x8*)(vt_ + c * 16 * 128 + 32 * ks); } while (0)
#define P3_LOADQ(st_) do { const GAS bf16* q_ = (const GAS bf16*)(ws + WS_Q) + ((size_t)(bh * SEQ + P3_CC(st_) * 128 + 16 * w + fr)) * 128 + 8 * fq; \
            _Pragma("unroll") for (int ks = 0; ks < 4; ++ks) qf[ks] = *(const GAS bf16x8*)(q_ + 32 * ks); } while (0)
        P3_LOADK(0); P3_LOADV(0);
        for (int step = 0; step < 18; ++step) {
            const bool isctx = step < 2; const int cc = P3_CC(step);
            LBAR();
            { LAS unsigned char* dst = ktl + (F.tid >> 4) * LROW + (F.tid & 15) * 16;
#pragma unroll
              for (int j = 0; j < 4; ++j) { v4u o; const float kd = dec[(dir ? DT_KDB : DT_KDF) + h * 128 + 32 * j + (F.tid >> 4)]; o.x = pk2(bflo(kreg[j].x) * kd, bfhi(kreg[j].x) * kd); o.y = pk2(bflo(kreg[j].y) * kd, bfhi(kreg[j].y) * kd);
                  o.z = pk2(bflo(kreg[j].z) * kd, bfhi(kreg[j].z) * kd); o.w = pk2(bflo(kreg[j].w) * kd, bfhi(kreg[j].w) * kd); *(LAS v4u*)(dst + 32 * j * LROW) = o; } }
            if (step < 17) P3_LOADK(step + 1);
            if (!isctx) {
                const float qd = dec[(dir ? DT_QDB : DT_QDF) + h * 128 + 16 * w + fr];
                GAS bf16* yp = Y + ((size_t)(b * SEQ + cc * 128 + 16 * w + fr)) * 1024 + h * 256 + 4 * fq;
#pragma unroll
                for (int t = 0; t < 16; ++t) { f32x4 y = (f32x4){0.f, 0.f, 0.f, 0.f};
#pragma unroll
                    for (int ks = 0; ks < 4; ++ks) { const bf16x8 av = *(const LAS bf16x8*)(stl + (16 * t + fr) * LROW + (32 * ks + 8 * fq) * 2); y = mfma16(av, qf[ks], y); }
                    v2u o; o.x = pk2(y[0] * qd, y[1] * qd); o.y = pk2(y[2] * qd, y[3] * qd); *(GAS v2u*)(yp + 16 * t) = o; }
            }
            if (step >= 1 && step < 17) P3_LOADQ(step + 1);
            LBAR();
            if (step < 17) {
#pragma unroll
                for (int t = 0; t < 8; ++t) { S[t][0] = S[t][0] * blk; S[t][1] = S[t][1] * blk;
#pragma unroll
                    for (int ks = 0; ks < 4; ++ks) {
                        const LAS unsigned char* tp = ktl + (32 * ks + 8 * fq + ((F.lane & 15) >> 2)) * LROW + (2 * t + ((F.lane & 3) >> 1)) * 16 + 8 * (F.lane & 1);
                        const s16x4 a0 = __builtin_amdgcn_ds_read_tr16_b64_v4i16((LAS s16x4*)tp), a1 = __builtin_amdgcn_ds_read_tr16_b64_v4i16((LAS s16x4*)(tp + 4 * LROW));
                        const bf16x8 av = __builtin_shufflevector(a0, a1, 0, 1, 2, 3, 4, 5, 6, 7);
                        S[t][0] = mfma16(av, vf[0][ks], S[t][0]); S[t][1] = mfma16(av, vf[1][ks], S[t][1]); } }
#pragma unroll
                for (int t = 0; t < 8; ++t)
#pragma unroll
                    for (int c = 0; c < 2; ++c) { v2u o; o.x = pk2(S[t][c][0], S[t][c][1]); o.y = pk2(S[t][c][2], S[t][c][3]); *(LAS v2u*)(stl + (32 * w + 16 * c + fr) * LROW + (16 * t + 4 * fq) * 2) = o; }
                P3_LOADV(step + 1);
            }
        }
#undef P3_CC
#undef P3_LOADK
#undef P3_LOADV
#undef P3_LOADQ
        LBAR();
    }
}

__device__ __forceinline__ void p4_intra(const Args& a0, const Ctx& F0) {
    const Ctx F = fresh(F0); const Args a = fresh(a0);
    GAS unsigned char* ws = (GAS unsigned char*)a.ws; const GAS float* dec = (const GAS float*)(ws + WS_DEC);
    LAS unsigned char* kl = F.lds; LAS unsigned char* vl = F.lds + 128 * LROW; LAS unsigned char* pl = F.lds + 384 * LROW + F.wave * 16 * LROW;
    const int w = F.wave, fr = F.lane & 15, fq = F.lane >> 4;
    const GAS bf16* Yf = (const GAS bf16*)((GAS unsigned char*)a.out + DO_YF); const GAS bf16* Yb = (const GAS bf16*)((GAS unsigned char*)a.out + DO_YB); const GAS bf16* G = (const GAS bf16*)(ws + WS_G); GAS unsigned char* CAT = ws + WS_CAT;
    v4u kreg[4], vreg[8];
    const unsigned loff = (unsigned)(8 * F.tid);
#define P4_LOAD(it_) do { const int i_ = (it_); const int c_ = (i_ >> 2) & 15, bh_ = (i_ >> 6) * 4 + (i_ & 3); \
        const GAS bf16* kb_ = (const GAS bf16*)(ws + WS_K) + ((size_t)(bh_ * SEQ + c_ * 128)) * 128;            \
        const GAS bf16* vb_ = (const GAS bf16*)(ws + WS_VT) + (((size_t)bh_ * NCH + c_) * 256) * 128; \
        _Pragma("unroll") for (int j = 0; j < 4; ++j) { kreg[j] = *(const GAS v4u*)((kb_ + 4096 * j) + loff); vreg[j] = *(const GAS v4u*)((vb_ + 4096 * j) + loff); vreg[4 + j] = *(const GAS v4u*)((vb_ + 16384 + 4096 * j) + loff); } } while (0)
    {
    if ((int)blockIdx.x < NB * NCH * NH) P4_LOAD(blockIdx.x);
    for (int it = blockIdx.x; it < NB * NCH * NH; it += F.G) {
        const int b = it >> 6, cc = (it >> 2) & 15, h = it & 3, bh = b * 4 + h;
        bf16x8 qc[4];
        { const GAS bf16* q = (const GAS bf16*)(ws + WS_Q) + ((size_t)(bh * SEQ + cc * 128 + 16 * w + fr)) * 128;
#pragma unroll
          for (int ks = 0; ks < 4; ++ks) qc[ks] = *(const GAS bf16x8*)(q + 32 * ks + 8 * fq); }
        LBAR();
        { const int row = F.tid >> 4, seg = F.tid & 15;
#pragma unroll
          for (int j = 0; j < 4; ++j) { *(LAS v4u*)(kl + (row + 32 * j) * LROW + seg * 16) = kreg[j]; *(LAS v4u*)(vl + (row + 32 * j) * LROW + seg * 16) = vreg[j]; *(LAS v4u*)(vl + (128 + row + 32 * j) * LROW + seg * 16) = vreg[4 + j]; } }
        if (it + F.G < NB * NCH * NH) P4_LOAD(it + F.G);
        LBAR();
        const int n = 16 * w + fr;
        const size_t tok = (size_t)b * SEQ + cc * 128 + n; const size_t yo = tok * 1024 + h * 256 + 4 * fq;

        const float lgf2 = dec[DT_LGF + h] * 1.4426950408889634f, lgb2 = dec[DT_LGB + h] * 1.4426950408889634f;
#pragma unroll
        for (int t = 0; t < 8; ++t) { f32x4 s = (f32x4){0.f, 0.f, 0.f, 0.f};
#pragma unroll
            for (int ks = 0; ks < 4; ++ks) { const bf16x8 av = *(const LAS bf16x8*)(kl + (16 * t + fr) * LROW + (32 * ks + 8 * fq) * 2); s = mfma16(av, qc[ks], s); }
#pragma unroll
            for (int r = 0; r < 4; ++r) { const int m = 16 * t + 4 * fq + r, df = n - m; s[r] *= df >= 0 ? exp2f(lgf2 * (float)df) : exp2f(lgb2 * (float)(-df)); }
            v2u o; o.x = pk2(s[0], s[1]); o.y = pk2(s[2], s[3]); *(LAS v2u*)(pl + fr * LROW + (16 * t + 4 * fq) * 2) = o; asm volatile("" ::: "memory"); }
        v2u yf[8], yb[8];
#pragma unroll
        for (int t = 0; t < 8; ++t) yf[t] = *(const GAS v2u*)(Yf + yo + 16 * t);
        LDS_WAIT(); __builtin_amdgcn_wave_barrier();
        bf16x8 pf[4];
#pragma unroll
        for (int ks = 0; ks < 4; ++ks) pf[ks] = *(const LAS bf16x8*)(pl + fr * LROW + (32 * ks + 8 * fq) * 2);
        f32x4 y[16];
        float sum = 0.f;
#pragma unroll
        for (int t = 0; t < 16; ++t) { y[t] = (f32x4){0.f, 0.f, 0.f, 0.f};
#pragma unroll
            for (int ks = 0; ks < 4; ++ks) { const bf16x8 av = *(const LAS bf16x8*)(vl + (16 * t + fr) * LROW + (32 * ks + 8 * fq) * 2); y[t] = mfma16(av, pf[ks], y[t]); }
            asm volatile("" ::: "memory"); }
#pragma unroll
        for (int hf = 0; hf < 2; ++hf) {
#pragma unroll
            for (int t = 0; t < 8; ++t) { if (hf) yf[t] = *(const GAS v2u*)(Yf + yo + 16 * (8 + t)); yb[t] = *(const GAS v2u*)(Yb + yo + 16 * (8 * hf + t)); }
#pragma unroll
            for (int t = 0; t < 8; ++t) { const v2u f = yf[t], f2 = yb[t]; f32x4& yy = y[8 * hf + t];
                yy[0] += bflo(f.x) + bflo(f2.x); yy[1] += bfhi(f.x) + bfhi(f2.x); yy[2] += bflo(f.y) + bflo(f2.y); yy[3] += bfhi(f.y) + bfhi(f2.y); sum += (yy[0] + yy[1]) + (yy[2] + yy[3]); }
            asm volatile("" ::: "memory"); }
        sum += __shfl_xor(sum, 16); sum += __shfl_xor(sum, 32);
        const float mu = sum * (1.f / 256.f); float var = 0.f;
#pragma unroll
        for (int t = 0; t < 16; ++t) { y[t] = y[t] - mu; var += (y[t][0] * y[t][0] + y[t][1] * y[t][1]) + (y[t][2] * y[t][2] + y[t][3] * y[t][3]); }
        var += __shfl_xor(var, 16); var += __shfl_xor(var, 32);
        const float rstd = __builtin_amdgcn_rsqf(var * (1.f / 256.f) + EPS);
#pragma unroll
        for (int hf = 0; hf < 2; ++hf) { v2u gin[8];
#pragma unroll
            for (int t = 0; t < 8; ++t) gin[t] = *(const GAS v2u*)(G + yo + 16 * (8 * hf + t));
#pragma unroll
            for (int t = 0; t < 8; ++t) { const v2u g = gin[t]; const f32x4 yy = y[8 * hf + t];
                const float rs4 = rstd * ASC8; unsigned w8 = 0; w8 = __builtin_amdgcn_cvt_pk_fp8_f32(yy[0] * rs4 * bflo(g.x), yy[1] * rs4 * bfhi(g.x), w8, false); w8 = __builtin_amdgcn_cvt_pk_fp8_f32(yy[2] * rs4 * bflo(g.y), yy[3] * rs4 * bfhi(g.y), w8, true);
                *(GAS unsigned*)(CAT + tok * 1536 + 512 + h * 256 + 16 * (8 * hf + t) + 4 * fq) = w8; }
            asm volatile("" ::: "memory"); }
    }
    LBAR();
    }
    {
        const Ctx F = fresh(F0); const Args a = fresh(a0); GAS unsigned char* ws = (GAS unsigned char*)a.ws;
        const GAS bf16* P = (const GAS bf16*)(ws + WS_P); GAS unsigned char* CAT = ws + WS_CAT;
        const int gw = F.vcu * NWAVES + F.wave, NGW = F.G * NWAVES, j = F.lane, grp = j >> 4, wd = 2 << grp;
        for (int t4 = 4 * gw; t4 < NT; t4 += 4 * NGW) {
            const int l = t4 & (SEQ - 1); const GAS bf16* base = P + (size_t)(t4 - l) * 512 + 8 * j;
            v4u rw[19];
#pragma unroll
            for (int i = 0; i < 19; ++i) { int r = l - 8 + i; r = r < 0 ? 0 : (r > SEQ - 1 ? SEQ - 1 : r); rw[i] = *(const GAS v4u*)(base + (size_t)r * 512); }
#pragma unroll
            for (int q = 0; q < 4; ++q) {
                int lo = l + q - (wd >> 1), hi = l + q + (wd >> 1); lo = lo < 0 ? 0 : lo; hi = hi > SEQ ? SEQ : hi;
                float acc[8];
#pragma unroll
                for (int e = 0; e < 8; ++e) acc[e] = 0.f;
#pragma unroll
                for (int i = 0; i < 16; ++i) { const int r = l + q - 8 + i; const float m = (r >= lo && r < hi) ? 1.f : 0.f; const v4u v = rw[q + i];
                    acc[0] += m * bflo(v.x); acc[1] += m * bfhi(v.x); acc[2] += m * bflo(v.y); acc[3] += m * bfhi(v.y); acc[4] += m * bflo(v.z); acc[5] += m * bfhi(v.z); acc[6] += m * bflo(v.w); acc[7] += m * bfhi(v.w); }
                const v4u s = rw[q + 8]; const float i4 = ASC8 * __builtin_amdgcn_rcpf((float)(hi - lo)); unsigned w0 = 0, w1 = 0;
                w0 = __builtin_amdgcn_cvt_pk_fp8_f32(acc[0] * i4 - ASC8 * bflo(s.x), acc[1] * i4 - ASC8 * bfhi(s.x), w0, false); w0 = __builtin_amdgcn_cvt_pk_fp8_f32(acc[2] * i4 - ASC8 * bflo(s.y), acc[3] * i4 - ASC8 * bfhi(s.y), w0, true);
                w1 = __builtin_amdgcn_cvt_pk_fp8_f32(acc[4] * i4 - ASC8 * bflo(s.z), acc[5] * i4 - ASC8 * bfhi(s.z), w1, false); w1 = __builtin_amdgcn_cvt_pk_fp8_f32(acc[6] * i4 - ASC8 * bflo(s.w), acc[7] * i4 - ASC8 * bfhi(s.w), w1, true);
                *(GAS v2u*)(CAT + (size_t)(t4 + q) * 1536 + 8 * j) = (v2u){w0, w1}; }
        }
    }
}

__device__ __forceinline__ void p7_norm(const Args& a0, const Ctx& F0) {
    const Ctx F = fresh(F0); const Args a = fresh(a0);
    const GAS float* mod = (const GAS float*)(a.ws + WS_MOD); const GAS bf16* X1 = (const GAS bf16*)(a.ws + WS_X1); GAS bf16* HF = (GAS bf16*)(a.ws + WS_HF);
    GAS unsigned* HQ = (GAS unsigned*)(a.ws + WS_HQ); GAS float* HS = (GAS float*)(a.ws + WS_HSC); const GAS float* g = (const GAS float*)a.norm_ffn_g;
    const int gw = F.vcu * NWAVES + F.wave, NGW = F.G * NWAVES, lane = F.lane;
    for (int m = 4 * gw; m < NT; m += 4 * NGW) {
        const GAS float* md = mod + (m >> 11) * 6144; f32x4 v[4][4]; float ss[4] = {0.f, 0.f, 0.f, 0.f};
#pragma unroll
        for (int r = 0; r < 4; ++r)
#pragma unroll
            for (int j = 0; j < 4; ++j) { const v2u xw = *((const GAS v2u*)(X1 + (size_t)(m + r) * DM) + lane + 64 * j); v[r][j] = (f32x4){bflo(xw.x), bfhi(xw.x), bflo(xw.y), bfhi(xw.y)}; }
#pragma unroll
        for (int r = 0; r < 4; ++r)
#pragma unroll
            for (int j = 0; j < 4; ++j) ss[r] += (v[r][j][0] * v[r][j][0] + v[r][j][1] * v[r][j][1]) + (v[r][j][2] * v[r][j][2] + v[r][j][3] * v[r][j][3]);
        f32x4 gm[4], sh[4];
#pragma unroll
        for (int j = 0; j < 4; ++j) { const int k = 4 * lane + 256 * j; gm[j] = *(const GAS f32x4*)(g + k) * (*(const GAS f32x4*)(md + 4096 + k) + 1.f); sh[j] = *(const GAS f32x4*)(md + 3072 + k); }
#pragma unroll
        for (int r = 0; r < 4; ++r) { const float rstd = __builtin_amdgcn_rsqf(wave_sum(ss[r]) * (1.f / DM) + EPS);
#pragma unroll
            for (int j = 0; j < 4; ++j) {
                const f32x4 y = v[r][j] * rstd * gm[j] + sh[j];
                v2u o; o.x = pk2(y[0], y[1]); o.y = pk2(y[2], y[3]); *((GAS v2u*)(HF + (size_t)(m + r) * DM) + lane + 64 * j) = o;
                float mx = fmaxf(fmaxf(fabsf(y[0]), fabsf(y[1])), fmaxf(fabsf(y[2]), fabsf(y[3])));
#pragma unroll
                for (int q = 1; q < 64; q <<= 1) mx = fmaxf(mx, __shfl_xor(mx, q));
                const float sc = mx > 0.f ? mx * (1.f / 119.f) : 1.f, inv = __builtin_amdgcn_rcpf(sc);
                unsigned hh = 0, hl = 0;
#pragma unroll
                for (int i = 0; i < 4; ++i) { const int qv = (int)rintf(y[i] * inv), lo = ((qv + 8) & 15) - 8, hi = (qv - lo) >> 4; hh |= (unsigned)(hi & 15) << (4 * i); hl |= (unsigned)(lo & 15) << (4 * i); }
                GAS unsigned short* hp = (GAS unsigned short*)HQ + ((size_t)(m + r) * 1024 + j * 256 + (lane >> 3) * 32) / 2 + (lane & 7);
                hp[0] = (unsigned short)hh; hp[8] = (unsigned short)hl;
                if (lane == 0) HS[(size_t)(m + r) * 4 + j] = sc; } }
    }
}

#define P9_CE(a_, b_) do { const float hi_ = fmaxf(a_, b_), lo_ = fminf(a_, b_); a_ = hi_; b_ = lo_; } while (0)
__device__ __forceinline__ void merge16_desc(float (&t)[16]) {
#pragma unroll
    for (int j = 8; j > 0; j >>= 1)
#pragma unroll
        for (int i = 0; i < 16; ++i) { const int l = i ^ j; if (l > i) P9_CE(t[i], t[l]); }
}
__device__ __forceinline__ void sort16_desc(float (&t)[16]) {
#pragma unroll
    for (int k = 2; k <= 16; k <<= 1)
#pragma unroll
        for (int j = k >> 1; j > 0; j >>= 1)
#pragma unroll
            for (int i = 0; i < 16; ++i) { const int l = i ^ j; if (l > i) { if ((i & k) == 0 || k == 16) P9_CE(t[i], t[l]); else P9_CE(t[l], t[i]); } }
}
__device__ __forceinline__ void top16_merge(float (&best)[16], float (&g)[16]) {
    sort16_desc(g);
#pragma unroll
    for (int i = 0; i < 16; ++i) best[i] = fmaxf(best[i], g[15 - i]);
    merge16_desc(best);
}
__device__ __forceinline__ float clean7(unsigned w) { return __builtin_bit_cast(float, w & 0xffffff80u); }
__device__ __forceinline__ void p9_route(const Args& a0, const Ctx& F0) {
    const Ctx F = fresh(F0); const Args a = fresh(a0);
    const GAS bf16* SC = (const GAS bf16*)(a.ws + WS_SC); GAS unsigned short* EI = (GAS unsigned short*)(a.ws + WS_EIDX); GAS float* GT = (GAS float*)(a.ws + WS_GATE);
    LAS unsigned* L = (LAS unsigned*)F.lds;
    const int gt = blockIdx.x * 512 + F.tid, NGT = F.G * 512;
    v4u nva, nvc, nvb, nvd;
    if (gt < NT * PH) { const GAS bf16* s0 = SC + (size_t)gt * 256; nva = *(const GAS v4u*)(s0); nvc = *(const GAS v4u*)(s0 + 8); nvb = *(const GAS v4u*)(s0 + 128); nvd = *(const GAS v4u*)(s0 + 136); }
    for (int it = gt; it < NT * PH; it += NGT) {
        const GAS bf16* src = SC + (size_t)it * 256;
        float t1[16], t2[16];
#pragma unroll
        for (int k0 = 0; k0 < 128; k0 += 16) {
            const v4u va = nva, vc = nvc, vb = nvb, vd = nvd;
            { const GAS bf16* nx = k0 + 16 < 128 ? src + k0 + 16 : (it + NGT < NT * PH ? src + (size_t)NGT * 256 : src);
              nva = *(const GAS v4u*)(nx); nvc = *(const GAS v4u*)(nx + 8); nvb = *(const GAS v4u*)(nx + 128); nvd = *(const GAS v4u*)(nx + 136); }
            __builtin_amdgcn_sched_barrier(0);
            const unsigned wa[8] = {va.x, va.y, va.z, va.w, vc.x, vc.y, vc.z, vc.w}, wb[8] = {vb.x, vb.y, vb.z, vb.w, vd.x, vd.y, vd.z, vd.w};
            float g1[16], g2[16];
#pragma unroll
            for (int j = 0; j < 8; ++j) { g1[2 * j] = __builtin_bit_cast(float, (wa[j] << 16) | (unsigned)(k0 + 2 * j)); g1[2 * j + 1] = __builtin_bit_cast(float, (wa[j] & 0xffff0000u) | (unsigned)(k0 + 2 * j + 1));
                g2[2 * j] = __builtin_bit_cast(float, (wb[j] << 16) | (unsigned)(k0 + 2 * j)); g2[2 * j + 1] = __builtin_bit_cast(float, (wb[j] & 0xffff0000u) | (unsigned)(k0 + 2 * j + 1)); }
            if (k0 == 0) { sort16_desc(g1); sort16_desc(g2);
#pragma unroll
                for (int i = 0; i < 16; ++i) { t1[i] = g1[i]; t2[i] = g2[i]; } }
            else { top16_merge(t1, g1); top16_merge(t2, g2); }
        }
#pragma unroll
        for (int i = 0; i < 16; ++i) { L[i * 512 + F.tid] = __builtin_bit_cast(unsigned, t1[i]); L[(16 + i) * 512 + F.tid] = __builtin_bit_cast(unsigned, t2[i]); }
        float t3[16];
        {
            float c[64];
#pragma unroll
            for (int q = 0; q < 64; ++q) c[q] = -INFINITY;
            int n = 0;
#pragma unroll
            for (int i = 0; i < 16; ++i)
#pragma unroll
                for (int j = 0; j < 16; ++j)
                    if ((i + 1) * (j + 1) <= 16) { const float s = clean7(__builtin_bit_cast(unsigned, t1[i])) + clean7(__builtin_bit_cast(unsigned, t2[j]));
                        c[n] = __builtin_bit_cast(float, (__builtin_bit_cast(unsigned, s) & 0xffffff00u) | (unsigned)(i * 16 + j)); ++n; }
            float g0[16], g1[16], g2[16], g3[16];
#pragma unroll
            for (int i = 0; i < 16; ++i) { g0[i] = c[i]; g1[i] = c[16 + i]; g2[i] = c[32 + i]; g3[i] = c[48 + i]; }
            sort16_desc(g0);
#pragma unroll
            for (int i = 0; i < 16; ++i) t3[i] = g0[i];
            top16_merge(t3, g1); top16_merge(t3, g2); top16_merge(t3, g3);
        }
        float best[16]; unsigned ex[16]; float mx = -INFINITY;
#pragma unroll
        for (int k = 0; k < 16; ++k) { const unsigned code = __builtin_bit_cast(unsigned, t3[k]) & 255u; const unsigned ua = L[(code >> 4) * 512 + F.tid], ub = L[(16 + (code & 15u)) * 512 + F.tid];
            best[k] = clean7(ua) + clean7(ub); ex[k] = (ua & 127u) * 128u + (ub & 127u); mx = fmaxf(mx, best[k]); }
        float den = 0.f;
#pragma unroll
        for (int k = 0; k < 16; ++k) { best[k] = __expf(best[k] - mx); den += best[k]; }
        const float inv = __builtin_amdgcn_rcpf(den);
        const int tk = it >> 3, hd = it & 7;
#pragma unroll
        for (int kk = 0; kk < 8; ++kk) { const size_t p = (size_t)tk * 128 + kk * 16 + hd * 2;
            *(GAS unsigned*)(EI + p) = ex[kk] | (ex[kk + 8] << 16); *(GAS f32x2*)(GT + p) = (f32x2){best[kk] * inv, best[kk + 8] * inv}; }
    }
}

typedef __bf16 bf16v2 __attribute__((ext_vector_type(2)));
__device__ __forceinline__ float dot2bf(unsigned a, unsigned b, float c) {
    return __builtin_amdgcn_fdot2_f32_bf16(__builtin_bit_cast(bf16v2, a), __builtin_bit_cast(bf16v2, b), c, false);
}
__device__ __forceinline__ float reduce32(float (&p)[32], int lane) {
    const bool b5 = lane & 32, b4 = lane & 16, b3 = lane & 8, b2 = lane & 4, b1 = lane & 2;
#pragma unroll
    for (int k = 0; k < 16; ++k) { const float send = b5 ? p[k] : p[k + 16], keep = b5 ? p[k + 16] : p[k]; p[k] = keep + __shfl_xor(send, 32); }
#pragma unroll
    for (int k = 0; k < 8; ++k) { const float send = b4 ? p[k] : p[k + 8], keep = b4 ? p[k + 8] : p[k]; p[k] = keep + __shfl_xor(send, 16); }
#pragma unroll
    for (int k = 0; k < 4; ++k) { const float send = b3 ? p[k] : p[k + 4], keep = b3 ? p[k + 4] : p[k]; p[k] = keep + __shfl_xor(send, 8); }
#pragma unroll
    for (int k = 0; k < 2; ++k) { const float send = b2 ? p[k] : p[k + 2], keep = b2 ? p[k + 2] : p[k]; p[k] = keep + __shfl_xor(send, 4); }
    { const float send = b1 ? p[0] : p[1], keep = b1 ? p[1] : p[0]; p[0] = keep + __shfl_xor(send, 2); }
    return p[0] + __shfl_xor(p[0], 1);
}
__device__ __forceinline__ void pu_dots(const Args& a0, const Ctx& F0) {
    const Ctx F = fresh(F0); const Args a = fresh(a0);
    GAS unsigned char* ws = (GAS unsigned char*)a.ws; const int sl = (blockIdx.x & 7) >> 1, nrk = F.G >> 2, wr = ((blockIdx.x >> 3) * 2 + (blockIdx.x & 1)) * NWAVES + F.wave, lane = F.lane, g = lane >> 3, sub = lane & 7;
    const __amdgpu_buffer_rsrc_t tab = __builtin_amdgcn_make_buffer_rsrc((void*)(a.ws + WS_U + (size_t)sl * (PEXP * 128)), 0, PEXP * 128, 0x00020000);
    const GAS unsigned short* EI = (const GAS unsigned short*)(ws + WS_EIDX); const GAS unsigned char* HQ = ws + WS_HQ; const GAS float* HS = (const GAS float*)(ws + WS_HSC);
    GAS bf16* PART = (GAS bf16*)(ws + WS_PART) + (size_t)sl * NT * 128;
    const bool b2 = sub & 4, b1 = sub & 2, b0 = sub & 1;
    for (int tk = wr; tk < NT; tk += nrk * NWAVES) {
        const v4u e0 = *(const GAS v4u*)(EI + (size_t)tk * 128 + g * 16), e1 = *(const GAS v4u*)(EI + (size_t)tk * 128 + g * 16 + 8);
        const v4u hh = *(const GAS v4u*)(HQ + (size_t)tk * DM + sl * 256 + sub * 32), hl = *(const GAS v4u*)(HQ + (size_t)tk * DM + sl * 256 + sub * 32 + 16); const float hs = HS[(size_t)tk * 4 + sl];
        const unsigned ew[8] = {e0.x, e0.y, e0.z, e0.w, e1.x, e1.y, e1.z, e1.w};
        v4u ur[16];
#pragma unroll
        for (int j = 0; j < 16; ++j) { const unsigned idx = (j & 1) ? (ew[j >> 1] >> 16) : (ew[j >> 1] & 0xffffu); ur[j] = __builtin_bit_cast(v4u, __builtin_amdgcn_raw_buffer_load_b128(tab, (int)(idx * 128u + (unsigned)sub * 16u), 0, 0)); }
        int d[16];
#pragma unroll
        for (int j = 0; j < 16; ++j) {
            int sh = __builtin_amdgcn_sdot8((int)ur[j].x, (int)hh.x, 0, false); sh = __builtin_amdgcn_sdot8((int)ur[j].y, (int)hh.y, sh, false); sh = __builtin_amdgcn_sdot8((int)ur[j].z, (int)hh.z, sh, false); sh = __builtin_amdgcn_sdot8((int)ur[j].w, (int)hh.w, sh, false);
            int s = __builtin_amdgcn_sdot8((int)ur[j].x, (int)hl.x, 0, false); s = __builtin_amdgcn_sdot8((int)ur[j].y, (int)hl.y, s, false); s = __builtin_amdgcn_sdot8((int)ur[j].z, (int)hl.z, s, false); s = __builtin_amdgcn_sdot8((int)ur[j].w, (int)hl.w, s, false);
            d[j] = sh * 16 + s; }
#pragma unroll
        for (int k = 0; k < 8; ++k) { const int send = b2 ? d[k] : d[k + 8], keep = b2 ? d[k + 8] : d[k]; d[k] = keep + ixor4(send); }
#pragma unroll
        for (int k = 0; k < 4; ++k) { const int send = b1 ? d[k] : d[k + 4], keep = b1 ? d[k + 4] : d[k]; d[k] = keep + ixor2(send); }
#pragma unroll
        for (int k = 0; k < 2; ++k) { const int send = b0 ? d[k] : d[k + 2], keep = b0 ? d[k + 2] : d[k]; d[k] = keep + ixor1(send); }
        *(GAS unsigned*)(PART + (size_t)tk * 128 + g * 16 + 2 * sub) = pk2((float)d[0] * hs, (float)d[1] * hs);
        __builtin_amdgcn_sched_barrier(0);
    }
}
__device__ __forceinline__ void pr_weights(const Args& a0, const Ctx& F0) {
    const Ctx F = fresh(F0); const Args a = fresh(a0);
    const GAS bf16* PART = (const GAS bf16*)(a.ws + WS_PART); const GAS float* GT = (const GAS float*)(a.ws + WS_GATE); GAS bf16* W = (GAS bf16*)(a.ws + WS_WGT);
    const GAS unsigned short* EI = (const GAS unsigned short*)(a.ws + WS_EIDX); const GAS float* USC = (const GAS float*)(a.ws + WS_USCALE); const GAS float* VSC = (const GAS float*)(a.ws + WS_VSCALE);
    const int gt = blockIdx.x * 512 + F.tid, NGT = F.G * 512;
    for (int e = gt; e < NT * 128 / 4; e += NGT) {
        f32x4 s = (f32x4){0.f, 0.f, 0.f, 0.f};
#pragma unroll
        for (int sl = 0; sl < 4; ++sl) { const v2u p = *(const GAS v2u*)(PART + (size_t)sl * NT * 128 + (size_t)e * 4); s[0] += bflo(p.x); s[1] += bfhi(p.x); s[2] += bflo(p.y); s[3] += bfhi(p.y); }
        const f32x4 gv = *(const GAS f32x4*)(GT + (size_t)e * 4); const v2u ei = *(const GAS v2u*)(EI + (size_t)e * 4); f32x4 w;
        const float us[4] = {USC[ei.x & 0xffffu], USC[ei.x >> 16], USC[ei.y & 0xffffu], USC[ei.y >> 16]};
        const float vs[4] = {VSC[ei.x & 0xffffu], VSC[ei.x >> 16], VSC[ei.y & 0xffffu], VSC[ei.y >> 16]};
#pragma unroll
        for (int j = 0; j < 4; ++j) { const float dv = s[j] * us[j]; w[j] = gv[j] * (0.5f * vs[j]) * dv * (1.f + erff(dv * 0.70710678118654752f)); }
        unsigned hi8 = 0, lo8 = 0;
#pragma unroll
        for (int j = 0; j < 4; ++j) w[j] = fminf(fmaxf(w[j], -1.71875f), 1.71875f);
        hi8 = __builtin_amdgcn_cvt_pk_fp8_f32(w[0] * 256.f, w[1] * 256.f, hi8, false); hi8 = __builtin_amdgcn_cvt_pk_fp8_f32(w[2] * 256.f, w[3] * 256.f, hi8, true);
        const f32x2 d01 = __builtin_amdgcn_cvt_pk_f32_fp8(hi8, false), d23 = __builtin_amdgcn_cvt_pk_f32_fp8(hi8, true);
        lo8 = __builtin_amdgcn_cvt_pk_fp8_f32((w[0] * 256.f - d01[0]) * 16.f, (w[1] * 256.f - d01[1]) * 16.f, lo8, false); lo8 = __builtin_amdgcn_cvt_pk_fp8_f32((w[2] * 256.f - d23[0]) * 16.f, (w[3] * 256.f - d23[1]) * 16.f, lo8, true);
        { GAS unsigned* wp = (GAS unsigned*)((GAS unsigned char*)W + (size_t)(e >> 5) * 256 + (e & 31) * 4); wp[0] = hi8; wp[32] = lo8; }
    }
}
constexpr int PV_BLK = 1032, PV_WREG = 16640;
typedef int v2i_t __attribute__((ext_vector_type(2)));
__device__ __forceinline__ void pv_accum(const Args& a0, const Ctx& F0) {
    const Ctx F = fresh(F0); const Args a = fresh(a0);
    GAS unsigned char* ws = (GAS unsigned char*)a.ws; const int sl = (blockIdx.x & 7) >> 1, nrk = F.G >> 2, wr = ((blockIdx.x >> 3) * 2 + (blockIdx.x & 1)) * NWAVES + F.wave, lane = F.lane, g = lane >> 3, sub = lane & 7;
    const __amdgpu_buffer_rsrc_t tab = __builtin_amdgcn_make_buffer_rsrc((void*)(a.ws + WS_V + (size_t)sl * (PEXP * 128)), 0, PEXP * 128, 0x00020000);
    const GAS unsigned short* EI = (const GAS unsigned short*)(ws + WS_EIDX); const GAS unsigned char* W8 = ws + WS_WGT; GAS bf16* PO = (GAS bf16*)(ws + WS_PEERO);
    LAS unsigned char* wl = F.lds + F.wave * PV_WREG;
    const int m = lane & 15, kg = lane >> 4;
    LAS unsigned char* rdp = wl + PV_BLK * m + 128 * ((kg & 1) + 4 * (kg >> 1));
    const int g1 = (kg >> 1) + 2 * (kg & 1);
    const bool s0 = (m >> 1) == 0, s1 = (m >> 1) == 2, s2 = (m >> 1) == 4, s3 = (m >> 1) == 6;
    const int step = nrk * NWAVES;
#define PV_IDX(tk_, E0, E1, A0, A1) do { const int t_ = (tk_) < NT ? (tk_) : NT - 1; E0 = *(const GAS v4u*)(EI + (size_t)t_ * 128 + g * 16); E1 = *(const GAS v4u*)(EI + (size_t)t_ * 128 + g * 16 + 8); \
        A0 = *(const GAS v4u*)(W8 + (size_t)t_ * 256 + (m & 1) * 128 + 16 * g1); A1 = *(const GAS v4u*)(W8 + (size_t)t_ * 256 + (m & 1) * 128 + 64 + 16 * g1); } while (0)
#define PV_GATHER(E0, E1) do { const unsigned ew_[8] = {E0.x, E0.y, E0.z, E0.w, E1.x, E1.y, E1.z, E1.w}; \
        _Pragma("unroll") for (int j = 0; j < 16; ++j) { const unsigned idx = (j & 1) ? (ew_[j >> 1] >> 16) : (ew_[j >> 1] & 0xffffu); \
            __builtin_amdgcn_raw_ptr_buffer_load_lds(tab, (LAS void*)(wl + PV_BLK * j), 16, (int)(idx * 128u + (unsigned)sub * 16u), 0, 0, 0); } } while (0)
#define PV_SEL(S, A0, A1) (pg8::v8i_t){(int)(S ? A0.x : 0u), (int)(S ? A0.y : 0u), (int)(S ? A0.z : 0u), (int)(S ? A0.w : 0u), (int)(S ? A1.x : 0u), (int)(S ? A1.y : 0u), (int)(S ? A1.z : 0u), (int)(S ? A1.w : 0u)}
#define PV_RD(R, b_) const v2i_t R##a = __builtin_amdgcn_ds_read_tr4_b64_v2i32((LAS v2i_t*)(rdp + 8 * (b_))), R##b = __builtin_amdgcn_ds_read_tr4_b64_v2i32((LAS v2i_t*)(rdp + 256 + 8 * (b_)));
#define PV_RD4(P, q_) PV_RD(P##0, (q_)) PV_RD(P##1, 4 + (q_)) PV_RD(P##2, 8 + (q_)) PV_RD(P##3, 12 + (q_))
#define PV_MM(ACC, AQ, R) do { const pg8::v4i_t b4_ = (pg8::v4i_t){R##a[0], R##a[1], R##b[0], R##b[1]}; asm volatile("v_mfma_f32_16x16x128_f8f6f4 %0, %1, %2, %0 cbsz:0 blgp:4" : "+v"(ACC) : "v"(AQ), "v"(b4_)); } while (0)
#define PV_MM4(AQ, P) do { asm volatile("s_nop 4" ::: "memory"); PV_MM(acc0, AQ, P##0); PV_MM(acc1, AQ, P##1); PV_MM(acc2, AQ, P##2); PV_MM(acc3, AQ, P##3); } while (0)
#define PV_MATH(A0, A1) \
        const pg8::v8i_t aq0 = PV_SEL(s0, A0, A1), aq1 = PV_SEL(s1, A0, A1), aq2 = PV_SEL(s2, A0, A1), aq3 = PV_SEL(s3, A0, A1); \
        f32x4 acc0 = (f32x4){0.f, 0.f, 0.f, 0.f}, acc1 = acc0, acc2 = acc0, acc3 = acc0; \
        asm volatile("s_waitcnt vmcnt(0)" ::: "memory"); \
        PV_RD4(ra, 0) __builtin_amdgcn_sched_barrier(0); \
        asm volatile("s_waitcnt lgkmcnt(7)" ::: "memory"); PV_RD4(rb, 1) __builtin_amdgcn_sched_barrier(0);        \
        PV_MM4(aq0, ra); __builtin_amdgcn_sched_barrier(0); \
        asm volatile("s_waitcnt lgkmcnt(7)" ::: "memory"); PV_RD4(rc, 2) __builtin_amdgcn_sched_barrier(0); \
        PV_MM4(aq1, rb); __builtin_amdgcn_sched_barrier(0); \
        asm volatile("s_waitcnt lgkmcnt(7)" ::: "memory"); PV_RD4(rd, 3) __builtin_amdgcn_sched_barrier(0); \
        PV_MM4(aq2, rc); __builtin_amdgcn_sched_barrier(0); \
        PV_MM4(aq3, rd); \
        asm volatile("s_nop 15\n\ts_nop 15" : "+v"(acc0), "+v"(acc1), "+v"(acc2), "+v"(acc3));
#define PV_STORE(tk_) \
        GAS unsigned short* po_ = (GAS unsigned short*)(PO + (size_t)(tk_) * DM + sl * 256) + lane; \
        po_[0] = (unsigned short)(pk2((acc0[0] + acc0[1] * 0.0625f) * (1.f / 256.f), 0.f) & 0xffffu); po_[64] = (unsigned short)(pk2((acc1[0] + acc1[1] * 0.0625f) * (1.f / 256.f), 0.f) & 0xffffu); \
        po_[128] = (unsigned short)(pk2((acc2[0] + acc2[1] * 0.0625f) * (1.f / 256.f), 0.f) & 0xffffu); po_[192] = (unsigned short)(pk2((acc3[0] + acc3[1] * 0.0625f) * (1.f / 256.f), 0.f) & 0xffffu);
#define PV_COMPUTE(tk_, A0, A1) do { PV_MATH(A0, A1) PV_STORE(tk_) } while (0)
    v4u e0, e1, a0w, a1w;
    PV_IDX(wr, e0, e1, a0w, a1w);
    for (int tk = wr; tk < NT; tk += step) {
        PV_GATHER(e0, e1);
        const v4u wa0 = a0w, wa1 = a1w;
        __builtin_amdgcn_sched_barrier(0);
        PV_IDX(tk + step, e0, e1, a0w, a1w);
        __builtin_amdgcn_sched_barrier(0);
        PV_COMPUTE(tk, wa0, wa1);
        __builtin_amdgcn_sched_barrier(0);
    }
    LBAR();
}
__device__ __forceinline__ void pf_final(const Args& a0, const Ctx& F0) {
    constexpr bool PEER = true, from_x1 = true;
    const Ctx F = fresh(F0); const Args a = fresh(a0); const GAS bf16* X1 = (const GAS bf16*)(a.ws + WS_X1); const GAS float* XF = (const GAS float*)a.x;
    const GAS float* mod = (const GAS float*)(a.ws + WS_MOD); const GAS bf16* PO = (const GAS bf16*)(a.ws + WS_PEERO);
    const int gw = F.vcu * NWAVES + F.wave, NGW = F.G * NWAVES, lane = F.lane;
    for (int t0 = 2 * gw; t0 < NT; t0 += 2 * NGW) {
        const int b = t0 >> 11; f32x4 xv[2][4]; v2u pv[2][4];
#pragma unroll
        for (int r = 0; r < 2; ++r)
#pragma unroll
            for (int j = 0; j < 4; ++j) { const int k = 4 * lane + 256 * j; if (from_x1) { const v2u xw = *(const GAS v2u*)(X1 + (size_t)(t0 + r) * DM + k); xv[r][j] = (f32x4){bflo(xw.x), bfhi(xw.x), bflo(xw.y), bfhi(xw.y)}; } else xv[r][j] = *(const GAS f32x4*)(XF + (size_t)(t0 + r) * DM + k); if (PEER) pv[r][j] = *(const GAS v2u*)(PO + (size_t)(t0 + r) * DM + k); }
        f32x4 g2[4], fgv[4];
#pragma unroll
        for (int j = 0; j < 4; ++j) { const int k = 4 * lane + 256 * j; g2[j] = *(const GAS f32x4*)(mod + b * 6144 + 5120 + k); fgv[j] = *(const GAS f32x4*)((const GAS float*)a.final_g + k); }
#pragma unroll
        for (int r = 0; r < 2; ++r) { float ss = 0.f;
#pragma unroll
            for (int j = 0; j < 4; ++j) {
                if (PEER) { const v2u p = pv[r][j]; xv[r][j] = xv[r][j] + g2[j] * (f32x4){bflo(p.x), bfhi(p.x), bflo(p.y), bfhi(p.y)}; }
                ss += (xv[r][j][0] * xv[r][j][0] + xv[r][j][1] * xv[r][j][1]) + (xv[r][j][2] * xv[r][j][2] + xv[r][j][3] * xv[r][j][3]); }
            const float rstd = __builtin_amdgcn_rsqf(wave_sum(ss) * (1.f / DM) + EPS);
#pragma unroll
            for (int j = 0; j < 4; ++j) { const int k = 4 * lane + 256 * j; *(GAS f32x4*)((GAS float*)a.out + (size_t)(t0 + r) * DM + k) = xv[r][j] * rstd * fgv[j]; } }
    }
}

__global__ void __launch_bounds__(NWAVES * 64, 2) hybrid_fwd(Args a_) {
    extern __shared__ __attribute__((aligned(16))) unsigned char lds[];
    Ctx F; F.lds = (LAS unsigned char*)lds; F.tid = threadIdx.x; F.lane = F.tid & 63; F.wave = __builtin_amdgcn_readfirstlane(F.tid >> 6);
    F.G = gridDim.x; { const int bx = blockIdx.x; F.vcu = (F.G % 8 == 0) ? (bx % 8) * (F.G / 8) + bx / 8 : bx; }
    volatile LAS unsigned* MISC = (volatile LAS unsigned*)(F.lds + LDSCTL_OFF);
    for (int u = F.tid; u < (LDS_BYTES - LDSCTL_OFF) / 4; u += NWAVES * 64) ((LAS unsigned*)(F.lds + LDSCTL_OFF))[u] = 0u;
    __syncthreads();
    unsigned* ctl = (unsigned*)(a_.ws + WS_CTL);
    (void)xcd_barrier_post(ctl + CW_BAR, MISC + 8);
#define GRID_BAR() do { const Args ab_ = fresh(a_); XcdBarrier bar_; bar_.bar = (unsigned*)(ab_.ws + WS_CTL) + CW_BAR; bar_.x = xb_xcc_id(); bar_.st = (volatile LAS unsigned*)((LAS unsigned char*)lds + LDSCTL_OFF) + 8; xcd_barrier(bar_, F.wave); } while (0)

    p0_prep(a_, F); GRID_BAR();
    p1_norm(a_, F); GRID_BAR();
    for (int jj = 0; jj < 6; ++jj) {
        const int job = jj < 3 ? (jj == 0 ? 2 : jj - 1) : jj;
        if (job == 3) { GRID_BAR(); p3_scan(a_, F); GRID_BAR(); p4_intra(a_, F); GRID_BAR(); }
        if (job == 4) GRID_BAR();
        if (job == 5) { GRID_BAR(); p7_norm(a_, F); GRID_BAR(); }
        const Args a = fresh(a_); pg8::Gemm g; EpiAll E; E.x = a.x; E.outf = a.out; E.ws = a.ws; E.mid_t = -1; pg8::StaticOrder S; bool f8 = false;
        const bf16* H = (const bf16*)((unsigned char*)a.out + DO_H); const bf16* H8 = (const bf16*)((unsigned char*)a.out + DO_H8);
        switch (job) {
            case 0: g = pg8::Gemm{(const bf16*)(a.ws + WS_WINS), H, NPS, NT + NTC, DM}; E.mode = EM_PROJS; break;
            case 1: g = pg8::Gemm{H, (const bf16*)(a.ws + WS_WINN), NT + NTC, NPQ, DM}; E.mode = EM_PROJN; break;
            case 2: g = pg8::Gemm{H8, (const bf16*)(a.ws + WS_WINN8), NT, NPG, DM / 2}; E.mode = EM_PROJG; f8 = true; break;
            case 3: g = pg8::Gemm{(const bf16*)(a.ws + WS_CAT), (const bf16*)(a.ws + WS_WPOOL), NT, DM, 768}; E.mode = EM_MERGE; E.mid_t = 4; f8 = true; break;
            case 4: g = pg8::Gemm{(const bf16*)(a.ws + WS_MERGED), (const bf16*)(a.ws + WS_WOUT), NT, DM, DM}; E.mode = EM_OUT; break;
            default: g = pg8::Gemm{(const bf16*)(a.ws + WS_HF), (const bf16*)(a.ws + WS_WEFF), NT, 2048, DM}; E.mode = EM_SCORE; break;
        }
        S.init(g.M, g.N, F.G, job == 1 ? (int)((blockIdx.x + (unsigned)(F.G >> 1)) % (unsigned)F.G) : (int)blockIdx.x);
        if (f8) pg8::gemm_phase<EpiAll, pg8::StaticOrder, true, true, true>(F.lds, g, S, E, F.wave);
        else pg8::gemm_phase<EpiAll, pg8::StaticOrder, true, true, false>(F.lds, g, S, E, F.wave);
    }
    GRID_BAR();
    p9_route(a_, F); GRID_BAR();
    pu_dots(a_, F); GRID_BAR();
    pr_weights(a_, F); GRID_BAR();
    pv_accum(a_, F); GRID_BAR();
    pf_final(a_, F);
}

extern "C" void kernel_launch(void* const* d_in, const int* in_sizes, int n_in, void* d_out, int out_size, void* d_ws, size_t ws_size, hipStream_t stream) {
    static int grid = 0;
    if (grid == 0) {
        if (n_in != 21 || in_sizes[0] != NT * DM || out_size != NT * DM || ws_size < WS_END) {
            fprintf(stderr, "kernel_launch: unexpected shapes: n_in %d in0 %d out %d ws %zu (need %zu)\n", n_in, n_in > 0 ? in_sizes[0] : -1, out_size, ws_size, (size_t)WS_END); grid = -1; return; }
        int dev = 0, cus = 0, per_cu = 0;
        if (hipGetDevice(&dev) != hipSuccess || hipDeviceGetAttribute(&cus, hipDeviceAttributeMultiprocessorCount, dev) != hipSuccess) { grid = -1; return; }
        if (hipFuncSetAttribute((const void*)hybrid_fwd, hipFuncAttributeMaxDynamicSharedMemorySize, LDS_BYTES) != hipSuccess) { fprintf(stderr, "kernel_launch: hipFuncSetAttribute failed\n"); grid = -1; return; }
        if (hipOccupancyMaxActiveBlocksPerMultiprocessor(&per_cu, (const void*)hybrid_fwd, NWAVES * 64, LDS_BYTES) != hipSuccess || per_cu < 1) { fprintf(stderr, "kernel_launch: occupancy query reports %d\n", per_cu); }
        (void)hipGetLastError();
        grid = cus;
    }
    if (grid < 0) return;
    if (hipMemsetAsync((char*)d_ws + WS_CTL, 0, CTL_ZERO_BYTES, stream) != hipSuccess) return;
    Args a{};
    const float** ap = (const float**)&a;
    for (int i = 0; i < 21; ++i) ap[i] = (const float*)d_in[i];
    a.out = (float*)d_out; a.ws = (unsigned char*)d_ws;
    hipLaunchKernelGGL(hybrid_fwd, dim3(grid), dim3(NWAVES * 64), LDS_BYTES, stream, a);
}
```

```cpp
#include <hip/hip_runtime.h>
#include <cstdio>
#include <cstdint>


namespace pg8 {
#define PG8_LAS __attribute__((address_space(3)))
typedef unsigned short bf16_t;
typedef short bf16x8 __attribute__((ext_vector_type(8)));
typedef float f32x4 __attribute__((ext_vector_type(4)));
typedef unsigned u32x4 __attribute__((ext_vector_type(4)));
constexpr int BM = 256, BK = 64, HALF = 128, HTB = HALF * BK * 2  , STAGE_BYTES = 8 * HTB, NXCD = 8, WGM = 8;

__host__ __device__ __forceinline__ int lds_byte(int r, int c) { const int st = (r >> 4) * 2 + (c >> 5), rr = r & 15, cc = c & 31, ob = rr * 64 + cc * 2; return st * 1024 + (ob ^ (((ob >> 9) & 1) << 5)); }
__host__ __device__ __forceinline__ void stage_rc(int b, int& R, int& C) { const int st = b / 1024, sb = b % 1024, swz = sb ^ (((sb >> 9) & 1) << 5); R = (st >> 1) * 16 + swz / 64; C = (st & 1) * 32 + (swz % 64) / 2; }
__host__ __device__ __forceinline__ int perm32(int rho) { const int n = rho >> 4, i = rho & 15; return 8 * (i >> 2) + 4 * n + (i & 3); }

struct Unit { int pm, pn; };
struct Gemm { const bf16_t* A; const bf16_t* Bt; int M, N, K; };

struct StaticOrder {
    int nM, nN, nwg, G, c;
    __host__ __device__ void init(int M, int N, int G_, int c_) { nM = M / BM; nN = N / BM; nwg = nM * nN; G = G_; c = c_; }
    __host__ __device__ bool next(int i, Unit& u) const {
        const long L = (long)i * G + c; if (L >= nwg) return false;
        int wgid = (int)L; { const int q = nwg / NXCD, r = nwg % NXCD, xcd = wgid % NXCD, off = wgid / NXCD; wgid = (xcd < r ? xcd * (q + 1) : r * (q + 1) + (xcd - r) * q) + off; }
        const int nig = WGM * nN, gid = wgid / nig, fm = gid * WGM, gsz = (nM - fm) < WGM ? (nM - fm) : WGM;
        u.pm = fm + ((wgid % nig) % gsz); u.pn = (wgid % nig) / gsz; return true;
    }
    __device__ __forceinline__ void a_ready(const Unit&) const {}
    __device__ __forceinline__ void done(const Unit&) const {}
};
__device__ __forceinline__ unsigned cvt_pk_bf16(float lo, float hi) { unsigned r; asm volatile("v_cvt_pk_bf16_f32 %0, %1, %2" : "=v"(r) : "v"(lo), "v"(hi)); return r; }
typedef int v4i_t __attribute__((ext_vector_type(4))); typedef int v8i_t __attribute__((ext_vector_type(8)));
__device__ __forceinline__ v8i_t cat8(bf16x8 a, bf16x8 b) { const v4i_t x = __builtin_bit_cast(v4i_t, a), y = __builtin_bit_cast(v4i_t, b); return __builtin_shufflevector(x, y, 0, 1, 2, 3, 4, 5, 6, 7); }
template <class Epi, class Sched, bool ALIGN_EPI = false, bool SP2 = false, bool F8 = false>
__device__ __forceinline__ void gemm_phase(PG8_LAS unsigned char* lds, const Gemm g, const Sched& S, const Epi& E, int wave_id) {
    int tid; asm volatile("v_mbcnt_lo_u32_b32 %0, -1, 0\n\tv_mbcnt_hi_u32_b32 %0, -1, %0" : "=v"(tid)); tid += wave_id * 64;
    const int wid = __builtin_amdgcn_readfirstlane(tid >> 6), lane = tid & 63, wr = wid >> 2, wc = wid & 3, fr = lane & 15, fq = lane >> 4;
    const int K = g.K, nt = K / BK;
    unsigned voffA[2], voffB[2];
#pragma unroll
    for (int i = 0; i < 2; ++i) { int R, C; stage_rc(tid * 16 + i * 8192, R, C); const int Rb = Epi::PERM ? ((R & ~31) + perm32(R & 31)) : R;
        voffA[i] = (unsigned)(R * K + C) * 2u; voffB[i] = (unsigned)(Rb * K + C) * 2u; }
    const size_t kstep = (size_t)(BK * 2);
    const size_t hstep = (size_t)HALF * K * 2;
    const size_t tstep = 2 * hstep;
    const unsigned ldsw = (unsigned)wid * 1024u;
    const int aoff = lds_byte(wr * 64 + fr, fq * 8), boff = lds_byte(wc * 32 + fr, fq * 8);
#define PG8_SA(b, h) (((b) * 2 + (h)) * HTB)
#define PG8_SB(b, h) ((4 + (b) * 2 + (h)) * HTB)
#define PG8_STAGE(bufoff, gbase, voff) do { _Pragma("unroll") for (int _i = 0; _i < 2; ++_i) \
        __builtin_amdgcn_global_load_lds((const unsigned*)((const char*)(gbase) + (voff)[_i]), (PG8_LAS unsigned*)(lds + (bufoff) + ldsw + _i * 8192), 16, 0, 0); } while (0)
#define PG8_LDA(dst, b, h) do { _Pragma("unroll") for (int m = 0; m < 4; ++m) _Pragma("unroll") for (int k = 0; k < 2; ++k) dst[m][k] = *(const PG8_LAS bf16x8*)(lds + PG8_SA(b, h) + aoff + m * 2048 + k * 1024); } while (0)
#define PG8_LDB(dst, b, h) do { _Pragma("unroll") for (int n = 0; n < 2; ++n) _Pragma("unroll") for (int k = 0; k < 2; ++k) dst[n][k] = *(const PG8_LAS bf16x8*)(lds + PG8_SB(b, h) + boff + n * 2048 + k * 1024); } while (0)
#define PG8_MMA(ai, bj, At, Bt) do { __builtin_amdgcn_s_setprio(1); _Pragma("unroll") for (int m = 0; m < 4; ++m) _Pragma("unroll") for (int n = 0; n < 2; ++n) { \
        if constexpr (F8) { const v8i_t b8_ = cat8(Bt[n][0], Bt[n][1]), a8_ = cat8(At[m][0], At[m][1]); asm volatile("v_mfma_f32_16x16x128_f8f6f4 %0, %1, %2, %0" : "+v"(acc[ai][bj][m][n]) : "v"(b8_), "v"(a8_)); } \
        else { _Pragma("unroll") for (int k = 0; k < 2; ++k) acc[ai][bj][m][n] = __builtin_amdgcn_mfma_f32_16x16x32_bf16(Bt[n][k], At[m][k], acc[ai][bj][m][n], 0, 0, 0); } } __builtin_amdgcn_s_setprio(0); } while (0)
#define PG8_WAIT_V(n) asm volatile("s_waitcnt vmcnt(" #n ")" ::: "memory")
#define PG8_WAIT_L(n) asm volatile("s_waitcnt lgkmcnt(" #n ")" ::: "memory")
#define PG8_BAR __builtin_amdgcn_s_barrier()
#define PG8_SCHED __builtin_amdgcn_sched_barrier(0)
    Unit cur, nxt; int ui = 0;
    if (!S.next(0, cur)) return;
    f32x4 acc[2][2][4][2];
#pragma unroll
    for (int a = 0; a < 2; ++a)
#pragma unroll
        for (int b = 0; b < 2; ++b)
#pragma unroll
            for (int m = 0; m < 4; ++m)
#pragma unroll
                for (int n = 0; n < 2; ++n) acc[a][b][m][n] = (f32x4){0.f, 0.f, 0.f, 0.f};
    bf16x8 At[4][2], B0[2][2], B1[2][2];
    const char* cA = (const char*)g.A + (size_t)cur.pm * tstep; const char* cB = (const char*)g.Bt + (size_t)cur.pn * tstep;
    S.a_ready(cur);
    if constexpr (SP2) {
        PG8_STAGE(PG8_SB(0, 0), cB, voffB); PG8_STAGE(PG8_SB(0, 1), cB + hstep, voffB); PG8_STAGE(PG8_SA(0, 0), cA, voffA); PG8_STAGE(PG8_SA(0, 1), cA + hstep, voffA);
        if (wr == 1) PG8_BAR;
        PG8_WAIT_V(2); PG8_BAR;
        PG8_STAGE(PG8_SB(1, 0), cB + kstep, voffB); PG8_STAGE(PG8_SA(1, 0), cA + kstep, voffA); PG8_STAGE(PG8_SB(1, 1), cB + hstep + kstep, voffB);
        PG8_WAIT_V(6); PG8_BAR;
    } else {
        PG8_STAGE(PG8_SB(0, 0), cB, voffB); PG8_STAGE(PG8_SA(0, 0), cA, voffA); PG8_STAGE(PG8_SB(0, 1), cB + hstep, voffB); PG8_STAGE(PG8_SA(0, 1), cA + hstep, voffA);
        if (wr == 1) PG8_BAR;
        PG8_WAIT_V(4); PG8_BAR;
        PG8_STAGE(PG8_SB(1, 0), cB + kstep, voffB); PG8_STAGE(PG8_SA(1, 0), cA + kstep, voffA); PG8_STAGE(PG8_SB(1, 1), cB + hstep + kstep, voffB);
        PG8_WAIT_V(6); PG8_BAR;
    }
    for (;;) {
        const bool has_next = S.next(ui + 1, nxt);
        const char* nA = has_next ? (const char*)g.A + (size_t)nxt.pm * tstep : cA; const char* nB = has_next ? (const char*)g.Bt + (size_t)nxt.pn * tstep : cB;
        for (int t = 0; t < nt; t += 2) {
            if (t == E.mid_t) { if constexpr (F8) asm volatile("s_nop 15\n\ts_nop 15" ::: "memory"); E.mid(acc, cur, wr, wc, fr, fq); }
            const bool last = (t == nt - 2);
            const char* a1 = cA + (size_t)(t + 1) * kstep;
            const char* a2 = last ? nA : cA + (size_t)(t + 2) * kstep; const char* b2 = last ? nB : cB + (size_t)(t + 2) * kstep;
            const char* a3 = a2 + kstep; const char* b3 = b2 + kstep;
            if (last && has_next) S.a_ready(nxt);
            if constexpr (SP2) {
            PG8_LDB(B0, 0, 0); PG8_LDB(B1, 0, 1); PG8_SCHED; PG8_LDA(At, 0, 0); PG8_STAGE(PG8_SA(1, 1), a1 + hstep, voffA);
            PG8_WAIT_V(8); PG8_WAIT_L(0); PG8_BAR; PG8_MMA(0, 0, At, B0); PG8_MMA(0, 1, At, B1); PG8_BAR; PG8_SCHED;
            PG8_LDA(At, 0, 1); PG8_STAGE(PG8_SB(0, 0), b2, voffB); PG8_STAGE(PG8_SB(0, 1), b2 + hstep, voffB); PG8_STAGE(PG8_SA(0, 0), a2, voffA);
            PG8_WAIT_V(8); PG8_WAIT_L(0); PG8_BAR; PG8_MMA(1, 0, At, B0); PG8_MMA(1, 1, At, B1); PG8_BAR; PG8_SCHED;
            PG8_LDB(B0, 1, 0); PG8_LDB(B1, 1, 1); PG8_SCHED; PG8_LDA(At, 1, 0); PG8_STAGE(PG8_SA(0, 1), a2 + hstep, voffA);
            PG8_WAIT_V(8); PG8_WAIT_L(0); PG8_BAR; PG8_MMA(0, 0, At, B0); PG8_MMA(0, 1, At, B1); PG8_BAR; PG8_SCHED;
            PG8_LDA(At, 1, 1); PG8_STAGE(PG8_SB(1, 0), b3, voffB); PG8_STAGE(PG8_SB(1, 1), b3 + hstep, voffB); PG8_STAGE(PG8_SA(1, 0), a3, voffA);
            PG8_WAIT_V(8); PG8_WAIT_L(0); PG8_BAR; PG8_MMA(1, 0, At, B0); PG8_MMA(1, 1, At, B1); PG8_BAR; PG8_SCHED;
            } else {
            PG8_LDB(B0, 0, 0); PG8_SCHED; PG8_LDA(At, 0, 0); PG8_STAGE(PG8_SA(1, 1), a1 + hstep, voffA);
            PG8_WAIT_L(8); PG8_BAR; PG8_WAIT_L(0); PG8_MMA(0, 0, At, B0); PG8_BAR; PG8_SCHED;
            PG8_LDB(B1, 0, 1); PG8_STAGE(PG8_SB(0, 0), b2, voffB);
            PG8_BAR; PG8_WAIT_L(0); PG8_MMA(0, 1, At, B1); PG8_BAR;
            PG8_LDA(At, 0, 1); PG8_STAGE(PG8_SA(0, 0), a2, voffA);
            PG8_BAR; PG8_WAIT_L(0); PG8_MMA(1, 0, At, B0); PG8_BAR; PG8_SCHED;
            PG8_STAGE(PG8_SB(0, 1), b2 + hstep, voffB);
            PG8_WAIT_V(6); PG8_BAR; PG8_MMA(1, 1, At, B1); PG8_BAR;
            PG8_LDB(B0, 1, 0); PG8_SCHED; PG8_LDA(At, 1, 0); PG8_STAGE(PG8_SA(0, 1), a2 + hstep, voffA);
            PG8_WAIT_L(8); PG8_BAR; PG8_WAIT_L(0); PG8_MMA(0, 0, At, B0); PG8_BAR; PG8_SCHED;
            PG8_LDB(B1, 1, 1); PG8_STAGE(PG8_SB(1, 0), b3, voffB);
            PG8_BAR; PG8_WAIT_L(0); PG8_MMA(0, 1, At, B1); PG8_BAR;
            PG8_LDA(At, 1, 1); PG8_STAGE(PG8_SA(1, 0), a3, voffA);
            PG8_BAR; PG8_WAIT_L(0); PG8_MMA(1, 0, At, B0); PG8_BAR; PG8_SCHED;
            PG8_STAGE(PG8_SB(1, 1), b3 + hstep, voffB);
            PG8_WAIT_V(6); PG8_BAR; PG8_MMA(1, 1, At, B1); PG8_BAR;
            }
        }
        if constexpr (ALIGN_EPI) { if (wr == 0) PG8_BAR; }
        if constexpr (F8) asm volatile("s_nop 15\n\ts_nop 15" ::: "memory");
        if constexpr (!Epi::AFTER_DRAIN) { E(acc, cur, wr, wc, fr, fq); S.done(cur); }
        if (!has_next) break;
#pragma unroll
        for (int a = 0; a < 2; ++a)
#pragma unroll
            for (int b = 0; b < 2; ++b)
#pragma unroll
                for (int m = 0; m < 4; ++m)
#pragma unroll
                    for (int n = 0; n < 2; ++n) acc[a][b][m][n] = (f32x4){0.f, 0.f, 0.f, 0.f};
        cur = nxt; cA = nA; cB = nB; ++ui;
        if constexpr (ALIGN_EPI) { if (wr == 1) PG8_BAR; }
    }
    PG8_WAIT_V(0);
    if constexpr (!ALIGN_EPI) { if (wr == 0) PG8_BAR; }
    PG8_BAR;
    if constexpr (Epi::AFTER_DRAIN) { E.fused(acc, cur, wr, wc, fr, fq, lds, wid, lane); S.done(cur); }
#undef PG8_SA
#undef PG8_SB
#undef PG8_STAGE
#undef PG8_LDA
#undef PG8_LDB
#undef PG8_MMA
#undef PG8_WAIT_V
#undef PG8_WAIT_L
#undef PG8_BAR
#undef PG8_SCHED
}
}

constexpr int NWAVES = 8;
constexpr int DM = 1024, NB = 32, SEQ = 2048, NT = NB * SEQ;
constexpr int LC = 256, NTC = NB * LC;
constexpr int INW = 5632, NH = 4, DK = 128, DV = 256, CH = 128, NCH = SEQ / CH;
constexpr int PH = 8, PNK = 128, PTOP = 16, PEXP = PNK * PNK;
constexpr float EPS = 1e-6f;
constexpr int NPQ = 1024;
constexpr int NPG = 3584;
constexpr int NPS = 1024;

constexpr size_t MiB = 1u << 20;
constexpr size_t WS_CTL = 0, CTL_ZERO_BYTES = 2 * MiB;
constexpr size_t WS_MOD = 65536;
constexpr size_t WS_COS = 2 * MiB, WS_SIN = WS_COS + 512 * 1024;
constexpr size_t WS_DEC = 4 * MiB;
constexpr size_t WS_WINN = 8 * MiB, WS_WINN8 = 10 * MiB, WS_WINS = 17 * MiB, WS_WPOOL = 20 * MiB, WS_WRET = 21 * MiB, WS_WOUT = 23 * MiB, WS_WEFF = 25 * MiB;
constexpr size_t WS_U = 32 * MiB, WS_V = 64 * MiB;
constexpr size_t WS_P = 96 * MiB, WS_Q = 160 * MiB, WS_K = 224 * MiB, WS_KTF = 288 * MiB, WS_KTB = 352 * MiB;
constexpr size_t WS_KC = 416 * MiB, WS_VTC = 432 * MiB;
constexpr size_t WS_VT = 480 * MiB, WS_G = 608 * MiB, WS_MG = 736 * MiB, WS_END = 1024 * MiB;
constexpr size_t WS_CAT = WS_KTF;
constexpr size_t WS_MERGED = WS_VT, WS_X1 = WS_P, WS_HF = WS_G, WS_SC = WS_MG;
constexpr size_t WS_EIDX = WS_KTB, WS_GATE = WS_KTB + 16 * MiB;
constexpr size_t WS_USCALE = WS_DEC + 16384, WS_VSCALE = WS_USCALE + 65536;
constexpr size_t WS_HQ = 400 * MiB, WS_HSC = 464 * MiB;
constexpr size_t WS_PART = WS_MG, WS_PEERO = WS_MG, WS_WGT = WS_VT;
constexpr size_t DO_H = 0, DO_HC = 128 * MiB, DO_H8 = 160 * MiB, DO_YF = 0, DO_YB = 128 * MiB;

constexpr int CW_TMO = 0, CW_DBG = 2, CW_BAR = 4096;
constexpr int DT_KDF = 0, DT_KDB = 512, DT_QDF = 1024, DT_QDB = 1536, DT_BLKF = 2048, DT_BLKB = 2052, DT_LGF = 2056, DT_LGB = 2060;

constexpr int LDS_BYTES = 155648;
constexpr int LDSCTL_OFF = 151552;

#define GAS __attribute__((address_space(1)))
#define LAS __attribute__((address_space(3)))
typedef unsigned short bf16;
typedef unsigned v4u __attribute__((ext_vector_type(4)));
typedef unsigned v2u __attribute__((ext_vector_type(2)));
typedef float f32x4 __attribute__((ext_vector_type(4)));
typedef float f32x2 __attribute__((ext_vector_type(2)));
typedef short bf16x8 __attribute__((ext_vector_type(8)));
typedef GAS unsigned gu32;
#define RLX_AGENT __ATOMIC_RELAXED, __HIP_MEMORY_SCOPE_AGENT
#define LDS_WAIT() asm volatile("s_waitcnt lgkmcnt(0)" ::: "memory")
#define VM_WAIT() asm volatile("s_waitcnt vmcnt(0)" ::: "memory")
__device__ __forceinline__ unsigned f2bf(float f) { unsigned u = __builtin_bit_cast(unsigned, f); return (u + 0x7fffu + ((u >> 16) & 1u)) >> 16; }
__device__ __forceinline__ unsigned pk2(float lo, float hi) { return f2bf(lo) | (f2bf(hi) << 16); }
__device__ __forceinline__ float bflo(unsigned w) { return __builtin_bit_cast(float, w << 16); }
__device__ __forceinline__ float bfhi(unsigned w) { return __builtin_bit_cast(float, w & 0xffff0000u); }
__device__ __forceinline__ float bf2f(bf16 v) { return __builtin_bit_cast(float, (unsigned)v << 16); }
__device__ __forceinline__ int ixor1(int v) { return __builtin_amdgcn_mov_dpp(v, 0xB1, 0xf, 0xf, true); }
__device__ __forceinline__ int ixor2(int v) { return __builtin_amdgcn_mov_dpp(v, 0x4E, 0xf, 0xf, true); }
__device__ __forceinline__ int ixor4(int v) { int r = __builtin_amdgcn_update_dpp(v, v, 0x104, 0xf, 0x5, false); return __builtin_amdgcn_update_dpp(r, v, 0x114, 0xf, 0xA, false); }
__device__ __forceinline__ int ixor8(int v) { return __builtin_amdgcn_mov_dpp(v, 0x128, 0xf, 0xf, true); }
__device__ __forceinline__ float fxor1(float v) { return __builtin_bit_cast(float, ixor1(__builtin_bit_cast(int, v))); }
__device__ __forceinline__ float fxor2(float v) { return __builtin_bit_cast(float, ixor2(__builtin_bit_cast(int, v))); }
__device__ __forceinline__ float fxor4(float v) { return __builtin_bit_cast(float, ixor4(__builtin_bit_cast(int, v))); }
__device__ __forceinline__ float fxor8(float v) { return __builtin_bit_cast(float, ixor8(__builtin_bit_cast(int, v))); }
__device__ __forceinline__ float red16(float lo, float hi) { asm volatile("v_nop\n\tv_nop\n\tv_permlane16_swap_b32 %0, %1" : "+v"(lo), "+v"(hi)); return lo + hi; }
__device__ __forceinline__ float red32(float lo, float hi) { asm volatile("v_nop\n\tv_nop\n\tv_permlane32_swap_b32 %0, %1" : "+v"(lo), "+v"(hi)); return lo + hi; }
__device__ __forceinline__ float wave_sum(float v) {
    v += fxor1(v); v += fxor2(v); v += fxor4(v); v += fxor8(v); v = red16(v, v); return red32(v, v);
}
__device__ __forceinline__ float sigmoidf_(float v) { return __builtin_amdgcn_rcpf(1.f + __expf(-v)); }
__device__ __forceinline__ f32x4 mfma16(bf16x8 a, bf16x8 b, f32x4 c) { return __builtin_amdgcn_mfma_f32_16x16x32_bf16(a, b, c, 0, 0, 0); }

__device__ __forceinline__ int lane_id() { int l; asm volatile("v_mbcnt_lo_u32_b32 %0, -1, 0\n\tv_mbcnt_hi_u32_b32 %0, -1, %0" : "=v"(l)); return l; }
#define XB_TMO      128
#define XB_XCNT(j)  (256  + 64 * (j))
#define XB_XSUB(j)  (1280 + 64 * (j))
#define XB_XGEN(j)  (2304 + 64 * (j))
#define XB_TOP      3328
#define XB_TOPGEN   3392
#define XCD_BAR_WORDS 3456
#define XB_SPIN_CAP (1u << 22)
__device__ __forceinline__ unsigned xb_ld(unsigned* p)              { return __hip_atomic_load(p, __ATOMIC_RELAXED, __HIP_MEMORY_SCOPE_AGENT); }
__device__ __forceinline__ unsigned xb_add(unsigned* p, unsigned v) { return __hip_atomic_fetch_add(p, v, __ATOMIC_RELAXED, __HIP_MEMORY_SCOPE_AGENT); }
__device__ __forceinline__ unsigned xb_xcc_id() { return (unsigned)__builtin_amdgcn_s_getreg((3 << 11) | 20) & 0xFu; }
#define XB_SPIN(cond, bar) do { unsigned _sp = 0; while (cond) { __builtin_amdgcn_s_sleep(1); \
    if ((++_sp & 255u) == 0u) { if (xb_ld(&(bar)[XB_TMO])) break; if (_sp > XB_SPIN_CAP) { atomicAdd(&(bar)[XB_TMO], 1u); break; } } } } while (0)
struct XcdBarrier { unsigned* bar; unsigned x; volatile LAS unsigned* st; };
__device__ __forceinline__ XcdBarrier xcd_barrier_post(unsigned* bar, volatile LAS unsigned* st) {
    XcdBarrier b; b.bar = bar; b.x = xb_xcc_id(); b.st = st;
    if (threadIdx.x == 0) (void)xb_add(&bar[XB_XCNT(b.x)], 1u);
    return b;
}
__device__ __forceinline__ void xcd_barrier_complete(unsigned* bar, unsigned x, unsigned& nloc, unsigned& nx) {
    const unsigned G = gridDim.x * gridDim.y * gridDim.z;
    unsigned sum, cnt, mine, sp = 0u;
    for (;;) {
        sum = 0u; cnt = 0u; mine = 0u;
#pragma unroll
        for (unsigned j = 0; j < 16; ++j) { const unsigned c = xb_ld(&bar[XB_XCNT(j)]); sum += c; cnt += (c > 0u) ? 1u : 0u; mine = (j == x) ? c : mine; }
        if (sum == G) break;
        __builtin_amdgcn_s_sleep(1);
        if ((++sp & 255u) == 0u) { if (xb_ld(&bar[XB_TMO])) break; if (sp > XB_SPIN_CAP) { atomicAdd(&bar[XB_TMO], 1u); break; } }
    }
    nloc = mine > 0u ? mine : 1u; nx = cnt > 0u ? cnt : 1u;
}
__device__ __forceinline__ void xcd_barrier(const XcdBarrier& b, int wave) {
    asm volatile("s_waitcnt vmcnt(0)" ::: "memory");
    __syncthreads();
    if (wave == 0 && lane_id() == 0) {
        unsigned* bar = b.bar; asm volatile("" : "+s"(bar));
        __builtin_amdgcn_s_waitcnt(0);
        unsigned nloc = b.st[0], nx = b.st[1];
        if (nloc == 0u) { xcd_barrier_complete(bar, b.x, nloc, nx); b.st[0] = nloc; b.st[1] = nx; }
        const unsigned old = xb_add(&bar[XB_XSUB(b.x)], 1u);
        const unsigned gen = old / nloc;
        if (old + 1u == (gen + 1u) * nloc) {
            __builtin_amdgcn_fence(__ATOMIC_RELEASE, "agent");
            asm volatile("s_waitcnt vmcnt(0)" ::: "memory");
            const unsigned og = xb_add(&bar[XB_TOP], 1u);
            const unsigned tg = og / nx;
            if (og + 1u == (tg + 1u) * nx) xb_add(&bar[XB_TOPGEN], 1u);
            else XB_SPIN(xb_ld(&bar[XB_TOPGEN]) == tg, bar);
            __builtin_amdgcn_fence(__ATOMIC_ACQUIRE, "agent");
            xb_add(&bar[XB_XGEN(b.x)], 1u);
            asm volatile("s_waitcnt vmcnt(0)" ::: "memory");
        } else {
            XB_SPIN(xb_ld(&bar[XB_XGEN(b.x)]) == gen, bar);
            __builtin_amdgcn_fence(__ATOMIC_ACQUIRE, "agent");
            asm volatile("s_waitcnt vmcnt(0)" ::: "memory");
        }
    }
    __syncthreads();
}

struct Args {
    const float *x, *c, *ctx, *c_ctx, *ada_w, *ada_b, *norm_mix_g, *norm_ffn_g, *w_in, *pool_w, *pool_scale, *pool_out, *ret_decay, *ret_norm_g, *ret_out, *w_out,
                *peer_wq, *peer_keys, *peer_u, *peer_v, *final_g;
    float* out; unsigned char* ws;
};

enum { EM_PROJN = 0, EM_PROJS = 1, EM_PROJG = 2, EM_MERGE = 3, EM_OUT = 5, EM_SCORE = 6 };
constexpr float WSC8 = 32.f, ASC8 = 4.f;
__device__ __forceinline__ v4u pack8(f32x4 a, f32x4 b) {
    v4u w; w.x = pg8::cvt_pk_bf16(a[0], a[1]); w.y = pg8::cvt_pk_bf16(a[2], a[3]); w.z = pg8::cvt_pk_bf16(b[0], b[1]); w.w = pg8::cvt_pk_bf16(b[2], b[3]); return w;
}
struct EpiAll {
    static constexpr bool PERM = true, AFTER_DRAIN = false;
    int mode, mid_t; const float* x; float* outf; unsigned char* ws;
    __device__ __forceinline__ void mid(f32x4 (&acc)[2][2][4][2], const pg8::Unit& u, int wr, int wc, int fr, int fq) const {
        asm volatile("" : "+v"(fr), "+v"(fq));
        const int row0 = u.pm * 256 + wr * 64 + fr, colt = u.pn * 256, c0 = wc * 32 + 8 * fq; const unsigned char* mg = ws + WS_MG;
#pragma unroll
        for (int ai = 0; ai < 2; ++ai)
#pragma unroll
            for (int m = 0; m < 4; ++m) { const size_t row = (size_t)(row0 + ai * 128 + m * 16);
#pragma unroll
                for (int bj = 0; bj < 2; ++bj) { const int col = colt + bj * 128 + c0; const v2u gp = *(const v2u*)(mg + row * 2048 + col), gr = *(const v2u*)(mg + row * 2048 + 1024 + col);
#pragma unroll
                    for (int j = 0; j < 4; ++j) { const unsigned r0 = (gr.x >> (8 * j)) & 255u, r1 = (gr.y >> (8 * j)) & 255u;
                        acc[ai][bj][m][0][j] *= (float)((gp.x >> (8 * j)) & 255u) * __builtin_amdgcn_rcpf((float)(r0 ? r0 : 1u)); acc[ai][bj][m][1][j] *= (float)((gp.y >> (8 * j)) & 255u) * __builtin_amdgcn_rcpf((float)(r1 ? r1 : 1u)); } } }
    }
    __device__ __forceinline__ void operator()(const f32x4 (&acc)[2][2][4][2], const pg8::Unit& u, int wr, int wc, int fr, int fq) const {
        asm volatile("" : "+v"(fr), "+v"(fq));
        const int row0 = u.pm * 256 + wr * 64 + fr, colt = u.pn * 256, c0 = wc * 32 + 8 * fq;
        if (mode == EM_PROJG) {
            {
                GAS bf16* dst; int ld, cb, act;
                if (colt < 512) { dst = (GAS bf16*)(ws + WS_P); ld = 512; cb = colt; act = 0; }
                else if (colt < 1536) { dst = (GAS bf16*)(ws + WS_G); ld = 1024; cb = colt - 512; act = 1; }
                else { dst = (GAS bf16*)(ws + WS_MG); ld = 1024; cb = (colt - 1536) >> 1; act = 2; }
#pragma unroll
                for (int ai = 0; ai < 2; ++ai)
#pragma unroll
                    for (int m = 0; m < 4; ++m) { GAS bf16* rowp = dst + (size_t)(row0 + ai * 128 + m * 16) * ld + cb + c0;
#pragma unroll
                        for (int bj = 0; bj < 2; ++bj) { f32x4 v0 = acc[ai][bj][m][0] * (1.f / WSC8), v1 = acc[ai][bj][m][1] * (1.f / WSC8);
                            if (act) {
#pragma unroll
                                for (int j = 0; j < 4; ++j) { const float s0 = sigmoidf_(v0[j]), s1 = sigmoidf_(v1[j]); v0[j] = act == 1 ? v0[j] * s0 : s0; v1[j] = act == 1 ? v1[j] * s1 : s1; } }
                            if (act == 2) { const f32x4 q0 = v0 * 255.f, q1 = v1 * 255.f;
                                v2u o; o.x = 0u; o.y = 0u;
                                o.x = __builtin_amdgcn_cvt_pk_u8_f32(q0[0], 0, o.x); o.x = __builtin_amdgcn_cvt_pk_u8_f32(q0[1], 1, o.x); o.x = __builtin_amdgcn_cvt_pk_u8_f32(q0[2], 2, o.x); o.x = __builtin_amdgcn_cvt_pk_u8_f32(q0[3], 3, o.x);
                                o.y = __builtin_amdgcn_cvt_pk_u8_f32(q1[0], 0, o.y); o.y = __builtin_amdgcn_cvt_pk_u8_f32(q1[1], 1, o.y); o.y = __builtin_amdgcn_cvt_pk_u8_f32(q1[2], 2, o.y); o.y = __builtin_amdgcn_cvt_pk_u8_f32(q1[3], 3, o.y);
                                *(GAS v2u*)((GAS unsigned char*)(dst + (size_t)(row0 + ai * 128 + m * 16) * ld) + (colt - 1536) + bj * 128 + c0) = o; }
                            else *(GAS v4u*)(rowp + bj * 128) = pack8(v0, v1); } }
            }
        } else if (mode == EM_PROJN) {
            {
                const bool isk = colt >= 512, cxr = u.pm * 256 >= NT; const int hb = (colt - (isk ? 512 : 0)) >> 7; const float sc = (isk ? 0.08838834764831845f : 1.f) * (1.f / WSC8);
                if (cxr && !isk) return;
                bf16* dst = (bf16*)(ws + (cxr ? WS_KC : (isk ? WS_K : WS_Q))); const float* cosT = (const float*)(ws + WS_COS); const float* sinT = (const float*)(ws + WS_SIN);
                const int i0 = c0 >> 1;
#pragma unroll
                for (int ai = 0; ai < 2; ++ai)
#pragma unroll
                    for (int m = 0; m < 4; ++m) { const int row = row0 + ai * 128 + m * 16, rr = cxr ? row - NT : row, b = cxr ? rr >> 8 : rr >> 11, l = cxr ? rr & 255 : rr & 2047, LQ = cxr ? 256 : 2048;
                        f32x4 cs = (f32x4){1.f, 1.f, 1.f, 1.f}, sn = (f32x4){0.f, 0.f, 0.f, 0.f}; if (!cxr) { cs = *(const f32x4*)(cosT + l * 64 + i0); sn = *(const f32x4*)(sinT + l * 64 + i0); }
#pragma unroll
                        for (int bj = 0; bj < 2; ++bj) { const f32x4 v0 = acc[ai][bj][m][0], v1 = acc[ai][bj][m][1]; f32x4 o0, o1;
                            o0[0] = (v0[0] * cs[0] - v0[1] * sn[0]) * sc; o0[1] = (v0[0] * sn[0] + v0[1] * cs[0]) * sc;
                            o0[2] = (v0[2] * cs[1] - v0[3] * sn[1]) * sc; o0[3] = (v0[2] * sn[1] + v0[3] * cs[1]) * sc;
                            o1[0] = (v1[0] * cs[2] - v1[1] * sn[2]) * sc; o1[1] = (v1[0] * sn[2] + v1[1] * cs[2]) * sc;
                            o1[2] = (v1[2] * cs[3] - v1[3] * sn[3]) * sc; o1[3] = (v1[2] * sn[3] + v1[3] * cs[3]) * sc;
                            if (isk) { const f32x4 k0 = o0 * 64.f, k1 = o1 * 64.f; v2u o; o.x = 0u; o.y = 0u;
                                o.x = __builtin_amdgcn_cvt_pk_fp8_f32(k0[0], k0[1], o.x, false); o.x = __builtin_amdgcn_cvt_pk_fp8_f32(k0[2], k0[3], o.x, true); o.y = __builtin_amdgcn_cvt_pk_fp8_f32(k1[0], k1[1], o.y, false); o.y = __builtin_amdgcn_cvt_pk_fp8_f32(k1[2], k1[3], o.y, true);
                                *(v2u*)((unsigned char*)dst + ((size_t)((b * 4 + hb + bj) * LQ + l)) * 128 + c0) = o; }
                            else { const f32x4 q0 = o0 * 8.f, q1 = o1 * 8.f; v2u o; o.x = 0u; o.y = 0u;
                                o.x = __builtin_amdgcn_cvt_pk_fp8_f32(q0[0], q0[1], o.x, false); o.x = __builtin_amdgcn_cvt_pk_fp8_f32(q0[2], q0[3], o.x, true); o.y = __builtin_amdgcn_cvt_pk_fp8_f32(q1[0], q1[1], o.y, false); o.y = __builtin_amdgcn_cvt_pk_fp8_f32(q1[2], q1[3], o.y, true);
                                *(v2u*)((unsigned char*)dst + ((size_t)((b * 4 + hb + bj) * LQ + l)) * 128 + 32 * ((c0 >> 3) & 3) + 8 * (c0 >> 5)) = o; } } }
            }
        } else if (mode == EM_PROJS) {
            const bool cx = colt >= NT; const int LL = cx ? 256 : 2048, lsh = cx ? 8 : 11;
            {
                unsigned char* vt = ws + (cx ? WS_VTC : WS_VT);
#pragma unroll
                for (int bj = 0; bj < 2; ++bj) { const int t0 = (cx ? colt - NT : colt) + bj * 128 + c0, b = t0 >> lsh, l0 = t0 & (LL - 1);
#pragma unroll
                    for (int ai = 0; ai < 2; ++ai)
#pragma unroll
                        for (int m = 0; m < 4; ++m) { const int chn = u.pm * 256 + ai * 128 + wr * 64 + m * 16 + fr, h = chn >> 8, dv = chn & 255;
                            const f32x4 v0 = acc[ai][bj][m][0] * (8.f / WSC8), v1 = acc[ai][bj][m][1] * (8.f / WSC8); v2u o; o.x = 0u; o.y = 0u;
                            o.x = __builtin_amdgcn_cvt_pk_fp8_f32(v0[0], v0[1], o.x, false); o.x = __builtin_amdgcn_cvt_pk_fp8_f32(v0[2], v0[3], o.x, true); o.y = __builtin_amdgcn_cvt_pk_fp8_f32(v1[0], v1[1], o.y, false); o.y = __builtin_amdgcn_cvt_pk_fp8_f32(v1[2], v1[3], o.y, true);
                            *(v2u*)(vt + (((size_t)(b * 4 + h) * (LL >> 7) + (l0 >> 7)) * 256 + dv) * 128 + 32 * (((l0 & 127) >> 3) & 3) + 8 * ((l0 & 127) >> 5)) = o; } }
            }
        } else if (mode == EM_MERGE) {
            const unsigned char* mg = ws + WS_MG + 1024; bf16* mer = (bf16*)(ws + WS_MERGED);
#pragma unroll
            for (int ai = 0; ai < 2; ++ai)
#pragma unroll
                for (int m = 0; m < 4; ++m) { const size_t row = (size_t)(row0 + ai * 128 + m * 16);
#pragma unroll
                    for (int bj = 0; bj < 2; ++bj) { const int col = colt + bj * 128 + c0;
                        const v2u gw = *(const v2u*)(mg + row * 2048 + col); f32x4 v0 = acc[ai][bj][m][0] * (1.f / (WSC8 * ASC8 * 255.f)), v1 = acc[ai][bj][m][1] * (1.f / (WSC8 * ASC8 * 255.f));
#pragma unroll
                        for (int j = 0; j < 4; ++j) { const unsigned r0 = (gw.x >> (8 * j)) & 255u, r1 = (gw.y >> (8 * j)) & 255u; v0[j] *= (float)(r0 ? r0 : 1u); v1[j] *= (float)(r1 ? r1 : 1u); }
                        *(v4u*)(mer + row * 1024 + col) = pack8(v0, v1); } }
        } else if (mode == EM_OUT) {
            const float* mod = (const float*)(ws + WS_MOD); bf16* x1 = (bf16*)(ws + WS_X1);
#pragma unroll
            for (int bj = 0; bj < 2; ++bj) { const int col = colt + bj * 128 + c0, b = row0 >> 11;
                const f32x4 g0 = *(const f32x4*)(mod + b * 6144 + 2048 + col), g1 = *(const f32x4*)(mod + b * 6144 + 2048 + col + 4);
#pragma unroll
                for (int ai = 0; ai < 2; ++ai)
#pragma unroll
                    for (int m = 0; m < 4; ++m) { const int row = row0 + ai * 128 + m * 16; const size_t o = (size_t)row * 1024 + col;
                        const f32x4 x0 = *(const f32x4*)(x + o), xb = *(const f32x4*)(x + o + 4);
                        *(v4u*)(x1 + o) = pack8(x0 + g0 * acc[ai][bj][m][0], xb + g1 * acc[ai][bj][m][1]); } }
        } else {
            bf16* sc = (bf16*)(ws + WS_SC);
#pragma unroll
            for (int ai = 0; ai < 2; ++ai)
#pragma unroll
                for (int m = 0; m < 4; ++m) { const int row = row0 + ai * 128 + m * 16;
                    unsigned char* chp = (unsigned char*)sc + ((((size_t)(row >> 3) * 4 + wc) * 64 + (row & 7) * 8 + (colt >> 8)) * 128) + 16 * fq;
#pragma unroll
                    for (int bj = 0; bj < 2; ++bj) *(v4u*)(chp + bj * 64) = pack8(acc[ai][bj][m][0], acc[ai][bj][m][1]); }
        }
    }
};

struct Ctx { LAS unsigned char* lds; int tid, lane, wave, vcu, G; };
__device__ __forceinline__ Ctx fresh(const Ctx& F0) {
    Ctx F; F.lds = F0.lds; int t = F0.wave * 64 + lane_id(); asm volatile("" : "+v"(t)); F.tid = t; F.lane = t & 63; F.wave = __builtin_amdgcn_readfirstlane(t >> 6);
    F.G = (int)gridDim.x; const int bx = (int)blockIdx.x; F.vcu = (F.G % 8 == 0) ? (bx % 8) * (F.G / 8) + bx / 8 : bx; return F; }
#define CAS __attribute__((address_space(4)))
__device__ __forceinline__ Args fresh(const Args& a0) {
#if defined(__HIP_DEVICE_COMPILE__)
    const CAS unsigned long long* kp = (const CAS unsigned long long*)__builtin_amdgcn_kernarg_segment_ptr(); asm volatile("" : "+s"(kp));
    Args a; unsigned long long* dst = (unsigned long long*)&a;
#pragma unroll
    for (int i = 0; i < (int)(sizeof(Args) / 8); ++i) dst[i] = kp[i];
    return a;
#else
    return a0;
#endif
}

__device__ __forceinline__ int mapN(int r) {
    const int sec = r < 512 ? 512 : 1024, q = r & 511, hh = q >> 7, p = q & 127; return sec + hh * 128 + (p & 1) * 64 + (p >> 1);
}
__device__ __forceinline__ int mapG(int r) {
    if (r < 512) return r;
    if (r < 1536) return 2560 + (r - 512);
    return 3584 + (r - 1536);
}
__device__ __forceinline__ int mapS(int r) {
    return 1536 + r;
}
template <int MAP, bool OUT8, bool KPERM = false> __device__ __forceinline__ void p0_transpose_item(const float* W, int ldw, int K, int nrows, const float* kscale, void* WTv, LAS float* scr, int item, int lane, int ldo = 0) {
    const int nblk = nrows / 32, kb = item / nblk, nb = item % nblk, k0 = 64 * kb, n0 = 32 * nb;
    const int rr = n0 + (lane & 31); const int sc = MAP == 1 ? mapN(rr) : (MAP == 2 ? mapS(rr) : (MAP == 3 ? mapG(rr) : rr));
#pragma unroll 8
    for (int i = 0; i < 32; ++i) { const int kk = 2 * i + (lane >> 5); float v = W[(size_t)(k0 + kk) * ldw + sc]; if (kscale) v *= kscale[k0 + kk]; scr[kk * 33 + (lane & 31)] = v; }
    LDS_WAIT(); asm volatile("" ::: "memory");
    const int c = lane & 7;
#pragma unroll
    for (int j = 0; j < 4; ++j) { const int n = (lane >> 3) + 8 * j; const LAS float* s = scr + (8 * c) * 33 + n;
        if (OUT8) { unsigned w0 = 0, w1 = 0;
            w0 = __builtin_amdgcn_cvt_pk_fp8_f32(s[0 * 33] * WSC8, s[1 * 33] * WSC8, w0, false); w0 = __builtin_amdgcn_cvt_pk_fp8_f32(s[2 * 33] * WSC8, s[3 * 33] * WSC8, w0, true);
            w1 = __builtin_amdgcn_cvt_pk_fp8_f32(s[4 * 33] * WSC8, s[5 * 33] * WSC8, w1, false); w1 = __builtin_amdgcn_cvt_pk_fp8_f32(s[6 * 33] * WSC8, s[7 * 33] * WSC8, w1, true);
            if (KPERM) { const int kk0 = k0 + 8 * c, hb = kk0 & ~255, dv = kk0 & 255;
                GAS unsigned char* rowp = (GAS unsigned char*)WTv + (size_t)(n0 + n) * (ldo ? ldo : K) + hb;
                *(GAS unsigned*)(rowp + 64 * ((dv >> 2) & 3) + 4 * (dv >> 4)) = w0; *(GAS unsigned*)(rowp + 64 * (((dv + 4) >> 2) & 3) + 4 * ((dv + 4) >> 4)) = w1; }
            else *(GAS v2u*)((unsigned char*)WTv + (size_t)(n0 + n) * (ldo ? ldo : K) + k0 + 8 * c) = (v2u){w0, w1}; }
        else { v4u o; o.x = pk2(s[0 * 33], s[1 * 33]); o.y = pk2(s[2 * 33], s[3 * 33]); o.z = pk2(s[4 * 33], s[5 * 33]); o.w = pk2(s[6 * 33], s[7 * 33]);
            *(GAS v4u*)((bf16*)WTv + (size_t)(n0 + n) * K + k0 + 8 * c) = o; } }
    LDS_WAIT(); asm volatile("" ::: "memory");
}

__device__ __forceinline__ void p0_prep(const Args& a0, const Ctx& F0) {
    const Ctx F = fresh(F0); const Args a = fresh(a0);
    unsigned char* ws = a.ws;
    {
        LAS float* s = (LAS float*)F.lds;
        float* mod = (float*)(ws + WS_MOD);
        for (int it = blockIdx.x; it < 256; it += F.G) {
            const int cl = F.tid % 24, kq = F.tid / 24, n = it * 24 + cl, k0 = kq * 64;
            __syncthreads();
            { f32x4 cv[17];
#pragma unroll
              for (int i = 0; i < 17; ++i) { const int e4 = F.tid + 512 * i, r = e4 >> 8, k4 = e4 & 255; cv[i] = e4 < 33 * 256 ? (r < 32 ? *(const GAS f32x4*)((const GAS float*)a.c + r * 1024 + 4 * k4) : *(const GAS f32x4*)((const GAS float*)a.c_ctx + 4 * k4)) : (f32x4){0.f, 0.f, 0.f, 0.f}; }
#pragma unroll
              for (int i = 0; i < 17; ++i) { const int e4 = F.tid + 512 * i; f32x4 v = cv[i];
#pragma unroll
                  for (int q = 0; q < 4; ++q) v[q] = v[q] * __builtin_amdgcn_rcpf(1.f + __expf(-v[q]));
                  if (e4 < 33 * 256) *(LAS f32x4*)(s + 4 * e4) = v; } }
            __syncthreads();
            float acc[33];
#pragma unroll
            for (int r = 0; r < 33; ++r) acc[r] = 0.f;
            if (kq < 16)
                for (int kk = 0; kk < 64; kk += 4) {
                    const float w0 = a.ada_w[(size_t)(k0 + kk) * 6144 + n], w1 = a.ada_w[(size_t)(k0 + kk + 1) * 6144 + n], w2 = a.ada_w[(size_t)(k0 + kk + 2) * 6144 + n], w3 = a.ada_w[(size_t)(k0 + kk + 3) * 6144 + n];
#pragma unroll
                    for (int r = 0; r < 33; ++r) { const f32x4 sv = *(const LAS f32x4*)(s + r * 1024 + k0 + kk); acc[r] += sv[0] * w0 + sv[1] * w1 + sv[2] * w2 + sv[3] * w3; }
                }
            __syncthreads();
            if (kq < 16) {
#pragma unroll
                for (int r = 0; r < 33; ++r) s[(kq * 33 + r) * 24 + cl] = acc[r]; }
            __syncthreads();
            for (int e = F.tid; e < 33 * 24; e += 512) { const int r = e / 24, c = e % 24; float t = 0.f;
#pragma unroll
                for (int q = 0; q < 16; ++q) t += s[(q * 33 + r) * 24 + c];
                mod[r * 6144 + it * 24 + c] = t + a.ada_b[it * 24 + c]; }
        }
        __syncthreads();
    }
    {
        LAS float* kl = (LAS float*)F.lds;
        LAS float* wl = kl + 128 * 133;
        bf16* weff = (bf16*)(ws + WS_WEFF);
        for (int it = blockIdx.x; it < 256; it += F.G) {
            const int hp = it >> 4, kb = it & 15;
            __syncthreads();
            for (int e = F.tid; e < 128 * 128; e += 512) { const int r = e >> 7, d = e & 127; kl[r * 133 + d] = a.peer_keys[(size_t)hp * 16384 + e]; }
            for (int e = F.tid; e < 64 * 128; e += 512) { const int r = e >> 7, d = e & 127; wl[r * 133 + d] = a.peer_wq[(size_t)(kb * 64 + r) * 2048 + hp * 128 + d]; }
            __syncthreads();
            const int kq = F.tid & 15, keyq = F.tid >> 4;
            float acc[4][4];
#pragma unroll
            for (int i = 0; i < 4; ++i)
#pragma unroll
                for (int j = 0; j < 4; ++j) acc[i][j] = 0.f;
            for (int d = 0; d < 128; ++d) {
                float kv[4], wv[4];
#pragma unroll
                for (int i = 0; i < 4; ++i) { kv[i] = kl[(4 * keyq + i) * 133 + d]; wv[i] = wl[(4 * kq + i) * 133 + d]; }
#pragma unroll
                for (int i = 0; i < 4; ++i)
#pragma unroll
                    for (int j = 0; j < 4; ++j) acc[i][j] += kv[i] * wv[j];
            }
#pragma unroll
            for (int i = 0; i < 4; ++i) { v2u o; o.x = pk2(acc[i][0], acc[i][1]); o.y = pk2(acc[i][2], acc[i][3]);
                *(GAS v2u*)(weff + (size_t)(hp * 128 + 4 * keyq + i) * 1024 + kb * 64 + 4 * kq) = o; }
        }
        __syncthreads();
    }
    {
        unsigned char* wp = ws + WS_WPOOL;
        for (int it = blockIdx.x; it < 128; it += F.G) {
            const int k8 = (it >> 1) * 8, n = (it & 1) * 512 + F.tid, g = k8 >> 7;
            float acc[8];
#pragma unroll
            for (int j = 0; j < 8; ++j) acc[j] = 0.f;
            for (int d0 = 0; d0 < 128; d0 += 16) {
                float po[16];
#pragma unroll
                for (int u = 0; u < 16; ++u) po[u] = a.pool_scale[g * 128 + d0 + u] * a.pool_out[(size_t)(g * 128 + d0 + u) * 1024 + n];
#pragma unroll
                for (int j = 0; j < 8; ++j)
#pragma unroll
                    for (int u = 0; u < 16; ++u) acc[j] += a.pool_w[(size_t)(k8 + j) * 128 + d0 + u] * po[u]; }
            unsigned w0 = 0, w1 = 0;
            w0 = __builtin_amdgcn_cvt_pk_fp8_f32(acc[0] * WSC8, acc[1] * WSC8, w0, false); w0 = __builtin_amdgcn_cvt_pk_fp8_f32(acc[2] * WSC8, acc[3] * WSC8, w0, true);
            w1 = __builtin_amdgcn_cvt_pk_fp8_f32(acc[4] * WSC8, acc[5] * WSC8, w1, false); w1 = __builtin_amdgcn_cvt_pk_fp8_f32(acc[6] * WSC8, acc[7] * WSC8, w1, true);
            *(v2u*)(wp + (size_t)n * 1536 + k8) = (v2u){w0, w1};
        }
    }
    {
        LAS float* scr = (LAS float*)(F.lds + F.wave * 8448);
        const int gw = F.vcu * NWAVES + F.wave, NGW = F.G * NWAVES;
        constexpr int I_N = (DM / 64) * (NPQ / 32), I_G = (DM / 64) * (NPG / 32), I_S = (DM / 64) * (NPS / 32), I_R = (DM / 64) * (DM / 32), I_O = I_R;
        for (int it = gw; it < I_N + I_G + I_S + I_R + I_O; it += NGW) {
            int r = it;
            if (r < I_N) { p0_transpose_item<1, true>(a.w_in, INW, DM, NPQ, nullptr, ws + WS_WINN, scr, r, F.lane); continue; } r -= I_N;
            if (r < I_G) { p0_transpose_item<3, true>(a.w_in, INW, DM, NPG, nullptr, ws + WS_WINN8, scr, r, F.lane); continue; } r -= I_G;
            if (r < I_S) { p0_transpose_item<2, true>(a.w_in, INW, DM, NPS, nullptr, ws + WS_WINS, scr, r, F.lane); continue; } r -= I_S;
            if (r < I_R) { p0_transpose_item<0, true, true>(a.ret_out, DM, DM, DM, a.ret_norm_g, ws + WS_WPOOL + 512, scr, r, F.lane, 1536); continue; } r -= I_R;
            p0_transpose_item<0, false>(a.w_out, DM, DM, DM, nullptr, ws + WS_WOUT, scr, r, F.lane);
        }
        const int gt = (blockIdx.x * 512 + F.tid), NGT = F.G * 512;
        float* cosT = (float*)(ws + WS_COS); float* sinT = (float*)(ws + WS_SIN);
        for (int e = gt; e < SEQ * 64; e += NGT) { const int l = e >> 6, i = e & 63; const float pos = (float)(i < 32 ? (l >> 6) : (l & 63));
            const float inv = exp2f(-(float)(i & 31) * (13.287712379549449f / 32.f)); float sv, cv; sincosf(pos * inv, &sv, &cv);
            cosT[e] = cv; sinT[e] = sv; }
        float* dec = (float*)(ws + WS_DEC);
        for (int e = gt; e < 512; e += NGT) { const int h = e >> 7, j = e & 127;
            const float xf = a.ret_decay[h], xb = a.ret_decay[4 + h]; const float lgf = -log1pf(expf(-xf)), lgb = -log1pf(expf(-xb));
            dec[DT_KDF + e] = expf(lgf * (float)(127 - j)); dec[DT_KDB + e] = expf(lgb * (float)j);
            dec[DT_QDF + e] = expf(lgf * (float)(j + 1)); dec[DT_QDB + e] = expf(lgb * (float)(128 - j));
            if (j == 0) { dec[DT_BLKF + h] = expf(lgf * 128.f); dec[DT_BLKB + h] = expf(lgb * 128.f); dec[DT_LGF + h] = lgf; dec[DT_LGB + h] = lgb; } }
        { GAS unsigned short* dv = (GAS unsigned short*)(ws + WS_V); GAS float* vsc = (GAS float*)(ws + WS_VSCALE); GAS unsigned short* du = (GAS unsigned short*)(ws + WS_U); GAS float* usc = (GAS float*)(ws + WS_USCALE);
          f32x4 nv[4], nu[4];
          if (gw < PEXP) {
#pragma unroll
              for (int j = 0; j < 4; ++j) { nv[j] = ((const GAS f32x4*)(a.peer_v + (size_t)gw * DM) + F.lane)[64 * j]; nu[j] = ((const GAS f32x4*)(a.peer_u + (size_t)gw * DM) + F.lane)[64 * j]; } }
          for (int row = gw; row < PEXP; row += NGW) { f32x4 v[4], u[4]; float m = 0.f, mu = 0.f;
#pragma unroll
              for (int j = 0; j < 4; ++j) { v[j] = nv[j]; u[j] = nu[j]; }
              { const int nr = row + NGW < PEXP ? row + NGW : row;
#pragma unroll
                for (int j = 0; j < 4; ++j) { nv[j] = ((const GAS f32x4*)(a.peer_v + (size_t)nr * DM) + F.lane)[64 * j]; nu[j] = ((const GAS f32x4*)(a.peer_u + (size_t)nr * DM) + F.lane)[64 * j]; } }
              __builtin_amdgcn_sched_barrier(0);
#pragma unroll
              for (int j = 0; j < 4; ++j) { m += (v[j][0] * v[j][0] + v[j][1] * v[j][1]) + (v[j][2] * v[j][2] + v[j][3] * v[j][3]); mu += (u[j][0] * u[j][0] + u[j][1] * u[j][1]) + (u[j][2] * u[j][2] + u[j][3] * u[j][3]); }
              m = wave_sum(m); mu = wave_sum(mu);
              const float sc = m > 0.f ? 0.5f * sqrtf(m * (1.f / DM)) : 1.f, inv = 1.f / sc, scu = mu > 0.f ? 0.35f * sqrtf(mu * (1.f / DM)) : 1.f, invu = 1.f / scu;
              if (F.lane == 0) { vsc[row] = sc; usc[row] = scu; }
#pragma unroll
              for (int j = 0; j < 4; ++j) { unsigned h = 0, hu = 0;
#pragma unroll
                  for (int i = 0; i < 4; ++i) { const float y = v[j][i] * inv, ay = fabsf(y);
                      const unsigned code = (unsigned)(ay > 0.25f) + (unsigned)(ay > 0.75f) + (unsigned)(ay > 1.25f) + (unsigned)(ay > 1.75f) + (unsigned)(ay > 2.5f) + (unsigned)(ay > 3.5f) + (unsigned)(ay > 5.f);
                      h |= (code | (y < 0.f ? 8u : 0u)) << (4 * i);
                      const int q = (int)fminf(fmaxf(rintf(u[j][i] * invu), -7.f), 7.f); hu |= (unsigned)(q & 15) << (4 * i); }
                  dv[((size_t)(j * PEXP + row)) * 64 + F.lane] = (unsigned short)h; du[((size_t)(j * PEXP + row)) * 64 + F.lane] = (unsigned short)hu; } } }
    }
}

__device__ __forceinline__ void norm_row2(const GAS float* x0, const GAS float* x1, const GAS float* g, const GAS float* sh0, const GAS float* sc0, const GAS float* sh1, const GAS float* sc1,
                                          GAS bf16* o0, GAS bf16* o1, GAS unsigned* q0, GAS unsigned* q1, int lane) {
    const GAS f32x4* xr0 = (const GAS f32x4*)x0 + lane; const GAS f32x4* xr1 = (const GAS f32x4*)x1 + lane;
    f32x4 v[4], u[4]; float s = 0.f, t = 0.f;
#pragma unroll
    for (int j = 0; j < 4; ++j) { v[j] = xr0[64 * j]; u[j] = xr1[64 * j]; }
#pragma unroll
    for (int j = 0; j < 4; ++j) { s += (v[j][0] * v[j][0] + v[j][1] * v[j][1]) + (v[j][2] * v[j][2] + v[j][3] * v[j][3]); t += (u[j][0] * u[j][0] + u[j][1] * u[j][1]) + (u[j][2] * u[j][2] + u[j][3] * u[j][3]); }
    const float rs = __builtin_amdgcn_rsqf(wave_sum(s) * (1.f / DM) + EPS), rt = __builtin_amdgcn_rsqf(wave_sum(t) * (1.f / DM) + EPS);
    GAS v2u* p0 = (GAS v2u*)o0 + lane; GAS v2u* p1 = (GAS v2u*)o1 + lane;
#pragma unroll
    for (int j = 0; j < 4; ++j) { const int k = 4 * lane + 256 * j; const f32x4 gg = *(const GAS f32x4*)(g + k);
        const f32x4 m0 = gg * (*(const GAS f32x4*)(sc0 + k) + 1.f), a0 = *(const GAS f32x4*)(sh0 + k);
        const f32x4 y0 = v[j] * rs * m0 + a0; v2u o; if (o0) { o.x = pk2(y0[0], y0[1]); o.y = pk2(y0[2], y0[3]); p0[64 * j] = o; }
        const f32x4 y1 = u[j] * rt * m0 + a0; if (o1) { o.x = pk2(y1[0], y1[1]); o.y = pk2(y1[2], y1[3]); p1[64 * j] = o; }
        if (q0) { unsigned w = 0; w = __builtin_amdgcn_cvt_pk_fp8_f32(y0[0], y0[1], w, false); w = __builtin_amdgcn_cvt_pk_fp8_f32(y0[2], y0[3], w, true); q0[lane + 64 * j] = w;
            w = __builtin_amdgcn_cvt_pk_fp8_f32(y1[0], y1[1], w, false); w = __builtin_amdgcn_cvt_pk_fp8_f32(y1[2], y1[3], w, true); q1[lane + 64 * j] = w; } }
}
__device__ __forceinline__ void p1_norm(const Args& a0, const Ctx& F0) {
    const Ctx F = fresh(F0); const Args a = fresh(a0);
    const GAS float* mod = (const GAS float*)(a.ws + WS_MOD);
    GAS bf16* H = (GAS bf16*)((GAS unsigned char*)a.out + DO_H);
    const int gw = F.vcu * NWAVES + F.wave, NGW = F.G * NWAVES;
    for (int m = 2 * gw; m < NT + NTC; m += 2 * NGW) {
        const GAS float* xs = m < NT ? (const GAS float*)a.x + (size_t)m * DM : (const GAS float*)a.ctx + (size_t)(m - NT) * DM;
        const GAS float* md = mod + (m < NT ? (m >> 11) : 32) * 6144;
        GAS unsigned* h8 = (GAS unsigned*)((GAS unsigned char*)a.out + DO_H8) + (size_t)m * (DM / 4);
        norm_row2(xs, xs + DM, (const GAS float*)a.norm_mix_g, md, md + 1024, md, md + 1024, (GAS bf16*)nullptr, (GAS bf16*)nullptr, h8, h8 + DM / 4, F.lane);
    }
}

#define LBAR() do { asm volatile("s_waitcnt lgkmcnt(0)" ::: "memory"); __builtin_amdgcn_s_barrier(); asm volatile("" ::: "memory"); } while (0)
typedef short s16x4 __attribute__((ext_vector_type(4)));
typedef __bf16 bf16v2_t __attribute__((ext_vector_type(2)));
__device__ __forceinline__ unsigned f8x2_bf16(unsigned w, bool hi) { return hi ? __builtin_bit_cast(unsigned, __builtin_amdgcn_cvt_scalef32_pk_bf16_fp8(w, 0.125f, true)) : __builtin_bit_cast(unsigned, __builtin_amdgcn_cvt_scalef32_pk_bf16_fp8(w, 0.125f, false)); }
__device__ __forceinline__ v4u f8x8_bf16(v2u w) { return (v4u){f8x2_bf16(w.x, false), f8x2_bf16(w.x, true), f8x2_bf16(w.y, false), f8x2_bf16(w.y, true)}; }
__device__ __forceinline__ unsigned f8x2_bf16k(unsigned w, bool hi) { return hi ? __builtin_bit_cast(unsigned, __builtin_amdgcn_cvt_scalef32_pk_bf16_fp8(w, 0.015625f, true)) : __builtin_bit_cast(unsigned, __builtin_amdgcn_cvt_scalef32_pk_bf16_fp8(w, 0.015625f, false)); }
__device__ __forceinline__ v4u f8x8_bf16k(v2u w) { return (v4u){f8x2_bf16k(w.x, false), f8x2_bf16k(w.x, true), f8x2_bf16k(w.y, false), f8x2_bf16k(w.y, true)}; }
constexpr int LROW = 272;
__device__ __forceinline__ void p3_scan(const Args& a0, const Ctx& F0) {
    const Ctx F = fresh(F0); const Args a = fresh(a0);
    GAS unsigned char* ws = (GAS unsigned char*)a.ws; const GAS float* dec = (const GAS float*)(ws + WS_DEC);
    LAS unsigned char* ktl = F.lds; LAS unsigned char* stl = F.lds + 128 * LROW;
    const int w = F.wave, fr = F.lane & 15, fq = F.lane >> 4;
    for (int it = blockIdx.x; it < NB * NH * 2; it += F.G) {
        const int b = it >> 3, h = (it >> 1) & 3, dir = it & 1, bh = b * 4 + h;
        GAS unsigned char* Y = (GAS unsigned char*)a.out + (dir ? DO_YB : DO_YF);
        f32x4 S[8][2];
#pragma unroll
        for (int t = 0; t < 8; ++t) { S[t][0] = (f32x4){0.f, 0.f, 0.f, 0.f}; S[t][1] = S[t][0]; }
        const float blk = dec[(dir ? DT_BLKB : DT_BLKF) + h];
        v4u kreg[2]; v2u vraw[2][4], qraw[4];
#pragma unroll
        for (int ks = 0; ks < 4; ++ks) qraw[ks] = (v2u){0u, 0u};
#define P3_CC(st_) (dir == 0 ? ((st_) < 2 ? (st_) : (st_) - 2) : ((st_) < 2 ? 1 - (st_) : 17 - (st_)))
#define P3_LOADK(st_) do { const int s_ = (st_); const bool cx_ = s_ < 2; const int LL_ = cx_ ? LC : SEQ; \
            const GAS unsigned char* src_ = (const GAS unsigned char*)(ws + (cx_ ? WS_KC : WS_K)) + ((size_t)bh * LL_ + P3_CC(s_) * 128) * 128 + 16 * F.tid;        \
            _Pragma("unroll") for (int j = 0; j < 2; ++j) kreg[j] = *(const GAS v4u*)(src_ + 8192 * j); } while (0)
#define P3_LOADV(st_) do { const int s_ = (st_); const bool cx_ = s_ < 2; const int LL_ = cx_ ? LC : SEQ; \
            const GAS unsigned char* vt_ = (const GAS unsigned char*)(ws + (cx_ ? WS_VTC : WS_VT)) + (((size_t)bh * (LL_ >> 7) + P3_CC(s_)) * 256 + 32 * w + fr) * 128 + 32 * fq;        \
            _Pragma("unroll") for (int c = 0; c < 2; ++c) { const v4u a_ = *(const GAS v4u*)(vt_ + c * 16 * 128), b_ = *(const GAS v4u*)(vt_ + c * 16 * 128 + 16); vraw[c][0] = (v2u){a_.x, a_.y}; vraw[c][1] = (v2u){a_.z, a_.w}; vraw[c][2] = (v2u){b_.x, b_.y}; vraw[c][3] = (v2u){b_.z, b_.w}; } } while (0)
#define P3_LOADQ(st_) do { const GAS unsigned char* q_ = (const GAS unsigned char*)(ws + WS_Q) + ((size_t)(bh * SEQ + P3_CC(st_) * 128 + 16 * w + fr)) * 128 + 32 * fq;        \
            { const v4u a_ = *(const GAS v4u*)(q_), b_ = *(const GAS v4u*)(q_ + 16); qraw[0] = (v2u){a_.x, a_.y}; qraw[1] = (v2u){a_.z, a_.w}; qraw[2] = (v2u){b_.x, b_.y}; qraw[3] = (v2u){b_.z, b_.w}; } } while (0)
        P3_LOADK(0); P3_LOADV(0);
        for (int step = 0; step < 18; ++step) {
            const bool isctx = step < 2; const int cc = P3_CC(step);
            LBAR();
            { LAS unsigned char* dst = ktl + (F.tid >> 3) * LROW + (F.tid & 7) * 32;
#pragma unroll
              for (int j = 0; j < 2; ++j) { const float kd = dec[(dir ? DT_KDB : DT_KDF) + h * 128 + 64 * j + (F.tid >> 3)] * 0.015625f; const unsigned kw[4] = {kreg[j].x, kreg[j].y, kreg[j].z, kreg[j].w}; unsigned ow[8];
#pragma unroll
                  for (int q = 0; q < 4; ++q) { const f32x2 lo = __builtin_amdgcn_cvt_pk_f32_fp8(kw[q], false), hi = __builtin_amdgcn_cvt_pk_f32_fp8(kw[q], true); ow[2 * q] = pk2(lo[0] * kd, lo[1] * kd); ow[2 * q + 1] = pk2(hi[0] * kd, hi[1] * kd); }
                  *(LAS v4u*)(dst + 64 * j * LROW) = (v4u){ow[0], ow[1], ow[2], ow[3]}; *(LAS v4u*)(dst + 64 * j * LROW + 16) = (v4u){ow[4], ow[5], ow[6], ow[7]}; } }
            if (step < 17) P3_LOADK(step + 1);
            if (!isctx) {
                const float qd = dec[(dir ? DT_QDB : DT_QDF) + h * 128 + 16 * w + fr];
                bf16x8 qf[4];
#pragma unroll
                for (int ks = 0; ks < 4; ++ks) qf[ks] = __builtin_bit_cast(bf16x8, f8x8_bf16(qraw[ks]));
                GAS unsigned char* yp = Y + ((size_t)(b * SEQ + cc * 128 + 16 * w + fr)) * 1024 + h * 256 + 64 * fq;
                unsigned ow[4];
#pragma unroll
                for (int t = 0; t < 16; ++t) { f32x4 y = (f32x4){0.f, 0.f, 0.f, 0.f};
#pragma unroll
                    for (int ks = 0; ks < 4; ++ks) { const bf16x8 av = *(const LAS bf16x8*)(stl + (16 * t + fr) * LROW + (32 * ks + 8 * fq) * 2); y = mfma16(av, qf[ks], y); }
                    unsigned o = 0; o = __builtin_amdgcn_cvt_pk_fp8_f32(y[0] * qd, y[1] * qd, o, false); o = __builtin_amdgcn_cvt_pk_fp8_f32(y[2] * qd, y[3] * qd, o, true); ow[t & 3] = o;
                    if ((t & 3) == 3) *(GAS v4u*)(yp + 4 * (t - 3)) = (v4u){ow[0], ow[1], ow[2], ow[3]}; }
            }
            if (step >= 1 && step < 17) P3_LOADQ(step + 1);
            LBAR();
            if (step < 17) {
                bf16x8 vf[2][4];
#pragma unroll
                for (int c = 0; c < 2; ++c)
#pragma unroll
                    for (int ks = 0; ks < 4; ++ks) vf[c][ks] = __builtin_bit_cast(bf16x8, f8x8_bf16(vraw[c][ks]));
#pragma unroll
                for (int t = 0; t < 8; ++t) { S[t][0] = S[t][0] * blk; S[t][1] = S[t][1] * blk;
#pragma unroll
                    for (int ks = 0; ks < 4; ++ks) {
                        const LAS unsigned char* tp = ktl + (32 * ks + 8 * fq + ((F.lane & 15) >> 2)) * LROW + (2 * t + ((F.lane & 3) >> 1)) * 16 + 8 * (F.lane & 1);
                        const s16x4 a0 = __builtin_amdgcn_ds_read_tr16_b64_v4i16((LAS s16x4*)tp), a1 = __builtin_amdgcn_ds_read_tr16_b64_v4i16((LAS s16x4*)(tp + 4 * LROW));
                        const bf16x8 av = __builtin_shufflevector(a0, a1, 0, 1, 2, 3, 4, 5, 6, 7);
                        S[t][0] = mfma16(av, vf[0][ks], S[t][0]); S[t][1] = mfma16(av, vf[1][ks], S[t][1]); } }
#pragma unroll
                for (int t = 0; t < 8; ++t)
#pragma unroll
                    for (int c = 0; c < 2; ++c) { v2u o; o.x = pk2(S[t][c][0], S[t][c][1]); o.y = pk2(S[t][c][2], S[t][c][3]); *(LAS v2u*)(stl + (32 * w + 16 * c + fr) * LROW + (16 * t + 4 * fq) * 2) = o; }
                P3_LOADV(step + 1);
            }
        }
#undef P3_CC
#undef P3_LOADK
#undef P3_LOADV
#undef P3_LOADQ
        LBAR();
    }
}

template <int HW> __device__ __forceinline__ void dpass_unit(const GAS bf16* P, GAS unsigned char* CAT, int t4, int choff) {
    const int l = t4 & (SEQ - 1); const GAS bf16* base = P + (size_t)(t4 - l) * 512 + choff;
    v4u rw[2 * HW + 7];
#pragma unroll
    for (int i = 0; i < 2 * HW + 7; ++i) { const int r = l - HW + i, rc = r < 0 ? 0 : (r > SEQ - 1 ? SEQ - 1 : r); const v4u v = *(const GAS v4u*)(base + (size_t)rc * 512); rw[i] = (r >= 0 && r < SEQ) ? v : (v4u){0u, 0u, 0u, 0u}; }
    float acc[8];
#pragma unroll
    for (int e = 0; e < 8; ++e) acc[e] = 0.f;
#pragma unroll
    for (int i = 0; i < 2 * HW; ++i) { const v4u v = rw[i];
        acc[0] += bflo(v.x); acc[1] += bfhi(v.x); acc[2] += bflo(v.y); acc[3] += bfhi(v.y); acc[4] += bflo(v.z); acc[5] += bfhi(v.z); acc[6] += bflo(v.w); acc[7] += bfhi(v.w); }
#pragma unroll
    for (int q = 0; q < 8; ++q) {
        if (q > 0) { const v4u va = rw[q + 2 * HW - 1], vd = rw[q - 1];
            acc[0] += bflo(va.x) - bflo(vd.x); acc[1] += bfhi(va.x) - bfhi(vd.x); acc[2] += bflo(va.y) - bflo(vd.y); acc[3] += bfhi(va.y) - bfhi(vd.y);
            acc[4] += bflo(va.z) - bflo(vd.z); acc[5] += bfhi(va.z) - bfhi(vd.z); acc[6] += bflo(va.w) - bflo(vd.w); acc[7] += bfhi(va.w) - bfhi(vd.w); }
        int lo = l + q - HW, hi = l + q + HW; lo = lo < 0 ? 0 : lo; hi = hi > SEQ ? SEQ : hi;
        const v4u s = rw[q + HW]; const float i4 = ASC8 * __builtin_amdgcn_rcpf((float)(hi - lo)); unsigned w0 = 0, w1 = 0;
        w0 = __builtin_amdgcn_cvt_pk_fp8_f32(acc[0] * i4 - ASC8 * bflo(s.x), acc[1] * i4 - ASC8 * bfhi(s.x), w0, false); w0 = __builtin_amdgcn_cvt_pk_fp8_f32(acc[2] * i4 - ASC8 * bflo(s.y), acc[3] * i4 - ASC8 * bfhi(s.y), w0, true);
        w1 = __builtin_amdgcn_cvt_pk_fp8_f32(acc[4] * i4 - ASC8 * bflo(s.z), acc[5] * i4 - ASC8 * bfhi(s.z), w1, false); w1 = __builtin_amdgcn_cvt_pk_fp8_f32(acc[6] * i4 - ASC8 * bflo(s.w), acc[7] * i4 - ASC8 * bfhi(s.w), w1, true);
        *(GAS v2u*)(CAT + (size_t)(t4 + q) * 1536 + choff) = (v2u){w0, w1}; }
}
__device__ __forceinline__ void p4_intra(const Args& a0, const Ctx& F0) {
    const Ctx F = fresh(F0); const Args a = fresh(a0);
    GAS unsigned char* ws = (GAS unsigned char*)a.ws; const GAS float* dec = (const GAS float*)(ws + WS_DEC);
    LAS unsigned char* kl = F.lds; LAS unsigned char* vl = F.lds + 128 * LROW; LAS unsigned char* pl = F.lds + 384 * LROW + F.wave * 16 * LROW;
    const int w = F.wave, fr = F.lane & 15, fq = F.lane >> 4;
    const GAS unsigned char* Yf = (const GAS unsigned char*)a.out + DO_YF; const GAS unsigned char* Yb = (const GAS unsigned char*)a.out + DO_YB;        const GAS bf16* G = (const GAS bf16*)(ws + WS_G); GAS unsigned char* CAT = ws + WS_CAT;
    v4u kreg[2], vreg[4]; v2u qnx[4];
    const unsigned loff = (unsigned)(8 * F.tid);
#define P4_LOAD(it_) do { const int i_ = (it_); const int c_ = (i_ >> 2) & 15, bh_ = (i_ >> 6) * 4 + (i_ & 3); \
        const GAS unsigned char* kb_ = (const GAS unsigned char*)(ws + WS_K) + ((size_t)(bh_ * SEQ + c_ * 128)) * 128 + 16 * F.tid;            \
        const GAS unsigned char* vb_ = (const GAS unsigned char*)(ws + WS_VT) + (((size_t)bh_ * NCH + c_) * 256) * 128 + 16 * F.tid;        \
        const GAS unsigned char* qb_ = (const GAS unsigned char*)(ws + WS_Q) + ((size_t)(bh_ * SEQ + c_ * 128 + 16 * w + fr)) * 128 + 32 * fq;        \
        _Pragma("unroll") for (int j = 0; j < 4; ++j) { if (j < 2) kreg[j] = *(const GAS v4u*)(kb_ + 8192 * j); vreg[j] = *(const GAS v4u*)(vb_ + 8192 * j); } { const v4u a_ = *(const GAS v4u*)(qb_), b_ = *(const GAS v4u*)(qb_ + 16); qnx[0] = (v2u){a_.x, a_.y}; qnx[1] = (v2u){a_.z, a_.w}; qnx[2] = (v2u){b_.x, b_.y}; qnx[3] = (v2u){b_.z, b_.w}; } } while (0)
    {
    if ((int)blockIdx.x < NB * NCH * NH) P4_LOAD(blockIdx.x);
    for (int it = blockIdx.x; it < NB * NCH * NH; it += F.G) {
        const int b = it >> 6, cc = (it >> 2) & 15, h = it & 3, bh = b * 4 + h;
        bf16x8 qc[4];
#pragma unroll
        for (int ks = 0; ks < 4; ++ks) qc[ks] = __builtin_bit_cast(bf16x8, f8x8_bf16(qnx[ks]));
        LBAR();
        { const int row = F.tid >> 4, seg = F.tid & 15;
#pragma unroll
          for (int j = 0; j < 4; ++j) { if (j < 2) { LAS unsigned char* kd_ = kl + ((F.tid >> 3) + 64 * j) * LROW + (F.tid & 7) * 32; *(LAS v4u*)kd_ = f8x8_bf16k((v2u){kreg[j].x, kreg[j].y}); *(LAS v4u*)(kd_ + 16) = f8x8_bf16k((v2u){kreg[j].z, kreg[j].w}); }
              LAS unsigned char* vd = vl + ((F.tid >> 3) + 64 * j) * LROW + 2 * (64 * (F.tid & 1) + 8 * ((F.tid & 7) >> 1));
              *(LAS v4u*)vd = f8x8_bf16((v2u){vreg[j].x, vreg[j].y}); *(LAS v4u*)(vd + 64) = f8x8_bf16((v2u){vreg[j].z, vreg[j].w}); } }
        if (it + F.G < NB * NCH * NH) P4_LOAD(it + F.G);
        LBAR();
        const int n = 16 * w + fr;
        const size_t tok = (size_t)b * SEQ + cc * 128 + n; const size_t yo = tok * 1024 + h * 256 + 4 * fq;

        const float lgf2 = dec[DT_LGF + h] * 1.4426950408889634f, lgb2 = dec[DT_LGB + h] * 1.4426950408889634f;
#pragma unroll
        for (int t = 0; t < 8; ++t) { f32x4 s = (f32x4){0.f, 0.f, 0.f, 0.f};
#pragma unroll
            for (int ks = 0; ks < 4; ++ks) { const bf16x8 av = *(const LAS bf16x8*)(kl + (16 * t + fr) * LROW + (32 * ks + 8 * fq) * 2); s = mfma16(av, qc[ks], s); }
#pragma unroll
            for (int r = 0; r < 4; ++r) { const int m = 16 * t + 4 * fq + r, df = n - m; s[r] *= df >= 0 ? exp2f(lgf2 * (float)df) : exp2f(lgb2 * (float)(-df)); }
            v2u o; o.x = pk2(s[0], s[1]); o.y = pk2(s[2], s[3]); *(LAS v2u*)(pl + fr * LROW + (16 * t + 4 * fq) * 2) = o; asm volatile("" ::: "memory"); }
        v4u yf4[4], yb4[4];
        { const size_t yl = tok * 1024 + h * 256 + 64 * fq;
#pragma unroll
          for (int q = 0; q < 4; ++q) { yf4[q] = *(const GAS v4u*)(Yf + yl + 16 * q); yb4[q] = *(const GAS v4u*)(Yb + yl + 16 * q); } }
        LDS_WAIT(); __builtin_amdgcn_wave_barrier();
        bf16x8 pf[4];
#pragma unroll
        for (int ks = 0; ks < 4; ++ks) pf[ks] = *(const LAS bf16x8*)(pl + fr * LROW + (32 * ks + 8 * fq) * 2);
        f32x4 y[16];
        float sum = 0.f;
#pragma unroll
        for (int t = 0; t < 16; ++t) { y[t] = (f32x4){0.f, 0.f, 0.f, 0.f};
#pragma unroll
            for (int ks = 0; ks < 4; ++ks) { const bf16x8 av = *(const LAS bf16x8*)(vl + (16 * t + fr) * LROW + (32 * ks + 8 * fq) * 2); y[t] = mfma16(av, pf[ks], y[t]); }
            asm volatile("" ::: "memory"); }
        v2u gin[8];
#pragma unroll
        for (int t = 0; t < 8; ++t) gin[t] = *(const GAS v2u*)(G + yo + 16 * t);
#pragma unroll
        for (int t = 0; t < 16; ++t) { const unsigned yfw = yf4[t >> 2][t & 3], ybw = yb4[t >> 2][t & 3]; const f32x2 f01 = __builtin_amdgcn_cvt_pk_f32_fp8(yfw, false), f23 = __builtin_amdgcn_cvt_pk_f32_fp8(yfw, true), b01 = __builtin_amdgcn_cvt_pk_f32_fp8(ybw, false), b23 = __builtin_amdgcn_cvt_pk_f32_fp8(ybw, true); f32x4& yy = y[t];
            yy[0] += f01[0] + b01[0]; yy[1] += f01[1] + b01[1]; yy[2] += f23[0] + b23[0]; yy[3] += f23[1] + b23[1]; sum += (yy[0] + yy[1]) + (yy[2] + yy[3]); }
        asm volatile("" ::: "memory");
        sum += __shfl_xor(sum, 16); sum += __shfl_xor(sum, 32);
        const float mu = sum * (1.f / 256.f); float var = 0.f;
#pragma unroll
        for (int t = 0; t < 16; ++t) { y[t] = y[t] - mu; var += (y[t][0] * y[t][0] + y[t][1] * y[t][1]) + (y[t][2] * y[t][2] + y[t][3] * y[t][3]); }
        var += __shfl_xor(var, 16); var += __shfl_xor(var, 32);
        const float rstd = __builtin_amdgcn_rsqf(var * (1.f / 256.f) + EPS);
        v2u gin2[8]; unsigned cw[4];
#pragma unroll
        for (int t = 0; t < 8; ++t) gin2[t] = *(const GAS v2u*)(G + yo + 16 * (8 + t));
#pragma unroll
        for (int hf = 0; hf < 2; ++hf) {
#pragma unroll
            for (int t = 0; t < 8; ++t) { const v2u g = hf ? gin2[t] : gin[t]; const f32x4 yy = y[8 * hf + t];
                const float rs4 = rstd * ASC8; unsigned w8 = 0; w8 = __builtin_amdgcn_cvt_pk_fp8_f32(yy[0] * rs4 * bflo(g.x), yy[1] * rs4 * bfhi(g.x), w8, false); w8 = __builtin_amdgcn_cvt_pk_fp8_f32(yy[2] * rs4 * bflo(g.y), yy[3] * rs4 * bfhi(g.y), w8, true);
                cw[t & 3] = w8;
                if ((t & 3) == 3) *(GAS v4u*)(CAT + tok * 1536 + 512 + h * 256 + 64 * fq + 4 * (8 * hf + t - 3)) = (v4u){cw[0], cw[1], cw[2], cw[3]}; }
            asm volatile("" ::: "memory"); }
    }
    LBAR();
    }
    {
        const Ctx F = fresh(F0); const Args a = fresh(a0); GAS unsigned char* ws = (GAS unsigned char*)a.ws;
        const GAS bf16* P = (const GAS bf16*)(ws + WS_P); GAS unsigned char* CAT = ws + WS_CAT;
        const int gw = F.vcu * NWAVES + F.wave, NGW = F.G * NWAVES, sb = F.lane >> 4, cj = F.lane & 15;
        for (int u = gw, kit = 0; u < (NT / 32) * 4; u += NGW, ++kit) {
            const int g = (u + kit) & 3, t4 = 32 * (u >> 2) + 8 * sb, choff = 128 * g + 8 * cj;
            if (g == 0) dpass_unit<1>(P, CAT, t4, choff); else if (g == 1) dpass_unit<2>(P, CAT, t4, choff); else if (g == 2) dpass_unit<4>(P, CAT, t4, choff); else dpass_unit<8>(P, CAT, t4, choff);
        }
    }
}

__device__ __forceinline__ void p7_norm(const Args& a0, const Ctx& F0) {
    const Ctx F = fresh(F0); const Args a = fresh(a0);
    const GAS float* mod = (const GAS float*)(a.ws + WS_MOD); const GAS bf16* X1 = (const GAS bf16*)(a.ws + WS_X1); GAS bf16* HF = (GAS bf16*)(a.ws + WS_HF);
    GAS unsigned* HQ = (GAS unsigned*)(a.ws + WS_HQ); GAS float* HS = (GAS float*)(a.ws + WS_HSC); const GAS float* g = (const GAS float*)a.norm_ffn_g;
    const int gw = F.vcu * NWAVES + F.wave, NGW = F.G * NWAVES, lane = F.lane;
    for (int m = 4 * gw; m < NT; m += 4 * NGW) {
        const GAS float* md = mod + (m >> 11) * 6144; f32x4 v[4][4]; float ss[4] = {0.f, 0.f, 0.f, 0.f};
#pragma unroll
        for (int r = 0; r < 4; ++r)
#pragma unroll
            for (int j = 0; j < 4; ++j) { const v2u xw = *((const GAS v2u*)(X1 + (size_t)(m + r) * DM) + lane + 64 * j); v[r][j] = (f32x4){bflo(xw.x), bfhi(xw.x), bflo(xw.y), bfhi(xw.y)}; }
#pragma unroll
        for (int r = 0; r < 4; ++r)
#pragma unroll
            for (int j = 0; j < 4; ++j) ss[r] += (v[r][j][0] * v[r][j][0] + v[r][j][1] * v[r][j][1]) + (v[r][j][2] * v[r][j][2] + v[r][j][3] * v[r][j][3]);
        f32x4 gm[4], sh[4];
#pragma unroll
        for (int j = 0; j < 4; ++j) { const int k = 4 * lane + 256 * j; gm[j] = *(const GAS f32x4*)(g + k) * (*(const GAS f32x4*)(md + 4096 + k) + 1.f); sh[j] = *(const GAS f32x4*)(md + 3072 + k); }
#pragma unroll
        for (int r = 0; r < 4; ++r) { const float rstd = __builtin_amdgcn_rsqf(wave_sum(ss[r]) * (1.f / DM) + EPS);
#pragma unroll
            for (int j = 0; j < 4; ++j) {
                const f32x4 y = v[r][j] * rstd * gm[j] + sh[j];
                v2u o; o.x = pk2(y[0], y[1]); o.y = pk2(y[2], y[3]); *((GAS v2u*)(HF + (size_t)(m + r) * DM) + lane + 64 * j) = o;
                float mx = fmaxf(fmaxf(fabsf(y[0]), fabsf(y[1])), fmaxf(fabsf(y[2]), fabsf(y[3])));
#pragma unroll
                for (int q = 1; q < 64; q <<= 1) mx = fmaxf(mx, __shfl_xor(mx, q));
                const float sc = mx > 0.f ? mx * (1.f / 119.f) : 1.f, inv = __builtin_amdgcn_rcpf(sc);
                unsigned hh = 0, hl = 0;
#pragma unroll
                for (int i = 0; i < 4; ++i) { const int qv = (int)rintf(y[i] * inv), lo = ((qv + 8) & 15) - 8, hi = (qv - lo) >> 4; hh |= (unsigned)(hi & 15) << (4 * i); hl |= (unsigned)(lo & 15) << (4 * i); }
                GAS unsigned short* hp = (GAS unsigned short*)HQ + ((size_t)(m + r) * 1024 + j * 256) / 2 + lane;
                hp[0] = (unsigned short)hh; hp[64] = (unsigned short)hl;
                if (lane == 0) HS[(size_t)(m + r) * 4 + j] = sc; } }
    }
}

#define P9_CE(a_, b_) do { const float hi_ = fmaxf(a_, b_), lo_ = fminf(a_, b_); a_ = hi_; b_ = lo_; } while (0)
__device__ __forceinline__ void merge16_desc(float (&t)[16]) {
#pragma unroll
    for (int j = 8; j > 0; j >>= 1)
#pragma unroll
        for (int i = 0; i < 16; ++i) { const int l = i ^ j; if (l > i) P9_CE(t[i], t[l]); }
}
__device__ __forceinline__ void sort16_desc(float (&t)[16]) {
#pragma unroll
    for (int p = 1; p < 16; p <<= 1)
#pragma unroll
        for (int k = p; k >= 1; k >>= 1)
#pragma unroll
            for (int j = k % p; j <= 15 - k; j += 2 * k)
#pragma unroll
                for (int i = 0; i < k; ++i)
                    if (i + j + k < 16 && (i + j) / (2 * p) == (i + j + k) / (2 * p)) P9_CE(t[i + j], t[i + j + k]);
}
__device__ __forceinline__ void top16_merge(float (&best)[16], float (&g)[16]) {
    sort16_desc(g);
#pragma unroll
    for (int i = 0; i < 16; ++i) best[i] = fmaxf(best[i], g[15 - i]);
    merge16_desc(best);
}
__device__ __forceinline__ float clean7(unsigned w) { return __builtin_bit_cast(float, w & 0xffffff80u); }
__device__ __forceinline__ void p9_route(const Args& a0, const Ctx& F0) {
    const Ctx F = fresh(F0); const Args a = fresh(a0);
    const GAS bf16* SC = (const GAS bf16*)(a.ws + WS_SC); GAS unsigned short* EI = (GAS unsigned short*)(a.ws + WS_EIDX); GAS bf16* GT = (GAS bf16*)(a.ws + WS_GATE);
    LAS unsigned* L = (LAS unsigned*)F.lds;
    const int gt = blockIdx.x * 512 + F.tid, NGT = F.G * 512;
    v4u nva, nvc, nvb, nvd;
#define P9_CH(it_, s_) ((const GAS unsigned char*)SC + ((((size_t)((it_) >> 6) * 4 + ((s_) >> 1)) * 64 + ((it_) & 63)) * 128) + 32 * ((s_) & 1))
    if (gt < NT * PH) { const GAS unsigned char* s0 = P9_CH(gt, 0); nva = *(const GAS v4u*)(s0); nvc = *(const GAS v4u*)(s0 + 16); nvb = *(const GAS v4u*)(s0 + 64); nvd = *(const GAS v4u*)(s0 + 80); }
    for (int it = gt; it < NT * PH; it += NGT) {
        float t1[16], t2[16];
#pragma unroll
        for (int k0 = 0; k0 < 128; k0 += 16) {
            const v4u va = nva, vc = nvc, vb = nvb, vd = nvd;
            { const GAS unsigned char* nx = k0 + 16 < 128 ? P9_CH(it, (k0 >> 4) + 1) : (it + NGT < NT * PH ? P9_CH(it + NGT, 0) : P9_CH(it, 0));
              nva = *(const GAS v4u*)(nx); nvc = *(const GAS v4u*)(nx + 16); nvb = *(const GAS v4u*)(nx + 64); nvd = *(const GAS v4u*)(nx + 80); }
            __builtin_amdgcn_sched_barrier(0);
            const unsigned wa[8] = {va.x, va.y, va.z, va.w, vc.x, vc.y, vc.z, vc.w}, wb[8] = {vb.x, vb.y, vb.z, vb.w, vd.x, vd.y, vd.z, vd.w};
            float g1[16], g2[16];
#pragma unroll
            for (int j = 0; j < 8; ++j) { g1[2 * j] = __builtin_bit_cast(float, (wa[j] << 16) | (unsigned)(k0 + 2 * j)); g1[2 * j + 1] = __builtin_bit_cast(float, (wa[j] & 0xffff0000u) | (unsigned)(k0 + 2 * j + 1));
                g2[2 * j] = __builtin_bit_cast(float, (wb[j] << 16) | (unsigned)(k0 + 2 * j)); g2[2 * j + 1] = __builtin_bit_cast(float, (wb[j] & 0xffff0000u) | (unsigned)(k0 + 2 * j + 1)); }
            if (k0 == 0) { sort16_desc(g1); sort16_desc(g2);
#pragma unroll
                for (int i = 0; i < 16; ++i) { t1[i] = g1[i]; t2[i] = g2[i]; } }
            else { top16_merge(t1, g1); top16_merge(t2, g2); }
        }
#pragma unroll
        for (int i = 0; i < 16; ++i) { L[i * 512 + F.tid] = __builtin_bit_cast(unsigned, t1[i]); L[(16 + i) * 512 + F.tid] = __builtin_bit_cast(unsigned, t2[i]); }
        float t3[16];
        {
            float c[64];
#pragma unroll
            for (int q = 0; q < 64; ++q) c[q] = -INFINITY;
            int n = 0;
#pragma unroll
            for (int i = 0; i < 16; ++i)
#pragma unroll
                for (int j = 0; j < 16; ++j)
                    if ((i + 1) * (j + 1) <= 16) { const float s = clean7(__builtin_bit_cast(unsigned, t1[i])) + clean7(__builtin_bit_cast(unsigned, t2[j]));
                        c[n] = __builtin_bit_cast(float, (__builtin_bit_cast(unsigned, s) & 0xffffff00u) | (unsigned)(i * 16 + j)); ++n; }
            float g0[16], g1[16], g2[16], g3[16];
#pragma unroll
            for (int i = 0; i < 16; ++i) { g0[i] = c[i]; g1[i] = c[16 + i]; g2[i] = c[32 + i]; g3[i] = c[48 + i]; }
            sort16_desc(g0);
#pragma unroll
            for (int i = 0; i < 16; ++i) t3[i] = g0[i];
            top16_merge(t3, g1); top16_merge(t3, g2); top16_merge(t3, g3);
        }
        float best[16]; unsigned ex[16]; float mx = -INFINITY;
#pragma unroll
        for (int k = 0; k < 16; ++k) { const unsigned code = __builtin_bit_cast(unsigned, t3[k]) & 255u; const unsigned ua = L[(code >> 4) * 512 + F.tid], ub = L[(16 + (code & 15u)) * 512 + F.tid];
            best[k] = clean7(ua) + clean7(ub); ex[k] = (ua & 127u) * 128u + (ub & 127u); mx = fmaxf(mx, best[k]); }
        float den = 0.f;
#pragma unroll
        for (int k = 0; k < 16; ++k) { best[k] = __expf(best[k] - mx); den += best[k]; }
        const float inv = __builtin_amdgcn_rcpf(den);
        const int tk = it >> 3, hd = it & 7;
#pragma unroll
        for (int kk = 0; kk < 8; ++kk) { const size_t p = (size_t)tk * 128 + kk * 16 + hd * 2;
            *(GAS unsigned*)(EI + p) = ex[kk] | (ex[kk + 8] << 16); *(GAS unsigned*)(GT + p) = pk2(best[kk] * inv, best[kk + 8] * inv); }
    }
}

typedef __bf16 bf16v2 __attribute__((ext_vector_type(2)));
__device__ __forceinline__ float dot2bf(unsigned a, unsigned b, float c) {
    return __builtin_amdgcn_fdot2_f32_bf16(__builtin_bit_cast(bf16v2, a), __builtin_bit_cast(bf16v2, b), c, false);
}
__device__ __forceinline__ float reduce32(float (&p)[32], int lane) {
    const bool b5 = lane & 32, b4 = lane & 16, b3 = lane & 8, b2 = lane & 4, b1 = lane & 2;
#pragma unroll
    for (int k = 0; k < 16; ++k) { const float send = b5 ? p[k] : p[k + 16], keep = b5 ? p[k + 16] : p[k]; p[k] = keep + __shfl_xor(send, 32); }
#pragma unroll
    for (int k = 0; k < 8; ++k) { const float send = b4 ? p[k] : p[k + 8], keep = b4 ? p[k + 8] : p[k]; p[k] = keep + __shfl_xor(send, 16); }
#pragma unroll
    for (int k = 0; k < 4; ++k) { const float send = b3 ? p[k] : p[k + 4], keep = b3 ? p[k + 4] : p[k]; p[k] = keep + __shfl_xor(send, 8); }
#pragma unroll
    for (int k = 0; k < 2; ++k) { const float send = b2 ? p[k] : p[k + 2], keep = b2 ? p[k + 2] : p[k]; p[k] = keep + __shfl_xor(send, 4); }
    { const float send = b1 ? p[0] : p[1], keep = b1 ? p[1] : p[0]; p[0] = keep + __shfl_xor(send, 2); }
    return p[0] + __shfl_xor(p[0], 1);
}
__device__ __forceinline__ void pu_dots(const Args& a0, const Ctx& F0) {
    const Ctx F = fresh(F0); const Args a = fresh(a0);
    GAS unsigned char* ws = (GAS unsigned char*)a.ws; const int sl = (blockIdx.x & 7) >> 1, nrk = F.G >> 2, wr = ((blockIdx.x >> 3) * 2 + (blockIdx.x & 1)) * NWAVES + F.wave, lane = F.lane, g = lane >> 3, sub = lane & 7;
    const __amdgpu_buffer_rsrc_t tab = __builtin_amdgcn_make_buffer_rsrc((void*)(a.ws + WS_U + (size_t)sl * (PEXP * 128)), 0, PEXP * 128, 0x00020000);
    const GAS unsigned short* EI = (const GAS unsigned short*)(ws + WS_EIDX); const GAS unsigned char* HQ = ws + WS_HQ; const GAS float* HS = (const GAS float*)(ws + WS_HSC);
    GAS unsigned char* PART = ws + WS_PART + (size_t)sl * NT * 128;
    const bool b2 = sub & 4, b1 = sub & 2, b0 = sub & 1;
    for (int tk = wr; tk < NT; tk += nrk * NWAVES) {
        const v4u e0 = *(const GAS v4u*)(EI + (size_t)tk * 128 + g * 16), e1 = *(const GAS v4u*)(EI + (size_t)tk * 128 + g * 16 + 8);
        const v4u hh = *(const GAS v4u*)(HQ + (size_t)tk * DM + sl * 256 + sub * 16), hl = *(const GAS v4u*)(HQ + (size_t)tk * DM + sl * 256 + 128 + sub * 16); const float hs = HS[(size_t)tk * 4 + sl];
        const unsigned ew[8] = {e0.x, e0.y, e0.z, e0.w, e1.x, e1.y, e1.z, e1.w};
        v4u ur[16];
#pragma unroll
        for (int j = 0; j < 16; ++j) { const unsigned idx = (j & 1) ? (ew[j >> 1] >> 16) : (ew[j >> 1] & 0xffffu); ur[j] = __builtin_bit_cast(v4u, __builtin_amdgcn_raw_buffer_load_b128(tab, (int)(idx * 128u + (unsigned)sub * 16u), 0, 0)); }
        int d[16];
#pragma unroll
        for (int j = 0; j < 16; ++j) {
            int sh = __builtin_amdgcn_sdot8((int)ur[j].x, (int)hh.x, 0, false); sh = __builtin_amdgcn_sdot8((int)ur[j].y, (int)hh.y, sh, false); sh = __builtin_amdgcn_sdot8((int)ur[j].z, (int)hh.z, sh, false); sh = __builtin_amdgcn_sdot8((int)ur[j].w, (int)hh.w, sh, false);
            int s = __builtin_amdgcn_sdot8((int)ur[j].x, (int)hl.x, 0, false); s = __builtin_amdgcn_sdot8((int)ur[j].y, (int)hl.y, s, false); s = __builtin_amdgcn_sdot8((int)ur[j].z, (int)hl.z, s, false); s = __builtin_amdgcn_sdot8((int)ur[j].w, (int)hl.w, s, false);
            d[j] = sh * 16 + s; }
#pragma unroll
        for (int k = 0; k < 8; ++k) { const int send = b2 ? d[k] : d[k + 8], keep = b2 ? d[k + 8] : d[k]; d[k] = keep + ixor4(send); }
#pragma unroll
        for (int k = 0; k < 4; ++k) { const int send = b1 ? d[k] : d[k + 4], keep = b1 ? d[k + 4] : d[k]; d[k] = keep + ixor2(send); }
#pragma unroll
        for (int k = 0; k < 2; ++k) { const int send = b0 ? d[k] : d[k + 2], keep = b0 ? d[k + 2] : d[k]; d[k] = keep + ixor1(send); }
        *(GAS unsigned short*)(PART + (size_t)tk * 128 + g * 16 + 2 * sub) = (unsigned short)__builtin_amdgcn_cvt_pk_fp8_f32((float)d[0] * (hs * 0.5f), (float)d[1] * (hs * 0.5f), 0u, false);
        __builtin_amdgcn_sched_barrier(0);
    }
}
__device__ __forceinline__ void pr_weights(const Args& a0, const Ctx& F0) {
    const Ctx F = fresh(F0); const Args a = fresh(a0);
    const GAS unsigned char* PART = (const GAS unsigned char*)(a.ws + WS_PART); const GAS bf16* GT = (const GAS bf16*)(a.ws + WS_GATE); GAS bf16* W = (GAS bf16*)(a.ws + WS_WGT);
    const GAS unsigned short* EI = (const GAS unsigned short*)(a.ws + WS_EIDX); const GAS float* USC = (const GAS float*)(a.ws + WS_USCALE); const GAS float* VSC = (const GAS float*)(a.ws + WS_VSCALE);
    const int gt = blockIdx.x * 512 + F.tid, NGT = F.G * 512;
    for (int e = gt; e < NT * 128 / 4; e += NGT) {
        f32x4 s = (f32x4){0.f, 0.f, 0.f, 0.f};
#pragma unroll
        for (int sl = 0; sl < 4; ++sl) { const unsigned p = *(const GAS unsigned*)(PART + (size_t)sl * NT * 128 + (size_t)e * 4); const f32x2 p01 = __builtin_amdgcn_cvt_pk_f32_fp8(p, false), p23 = __builtin_amdgcn_cvt_pk_f32_fp8(p, true); s[0] += p01[0]; s[1] += p01[1]; s[2] += p23[0]; s[3] += p23[1]; }
        s = s * 2.f;
        const v2u gw_ = *(const GAS v2u*)(GT + (size_t)e * 4); const f32x4 gv = (f32x4){bflo(gw_.x), bfhi(gw_.x), bflo(gw_.y), bfhi(gw_.y)}; const v2u ei = *(const GAS v2u*)(EI + (size_t)e * 4); f32x4 w;
        const float us[4] = {USC[ei.x & 0xffffu], USC[ei.x >> 16], USC[ei.y & 0xffffu], USC[ei.y >> 16]};
        const float vs[4] = {VSC[ei.x & 0xffffu], VSC[ei.x >> 16], VSC[ei.y & 0xffffu], VSC[ei.y >> 16]};
#pragma unroll
        for (int j = 0; j < 4; ++j) { const float dv = s[j] * us[j]; w[j] = gv[j] * (0.5f * vs[j]) * dv * (1.f + erff(dv * 0.70710678118654752f)); }
        unsigned hi8 = 0, lo8 = 0;
#pragma unroll
        for (int j = 0; j < 4; ++j) w[j] = fminf(fmaxf(w[j], -1.71875f), 1.71875f);
        hi8 = __builtin_amdgcn_cvt_pk_fp8_f32(w[0] * 256.f, w[1] * 256.f, hi8, false); hi8 = __builtin_amdgcn_cvt_pk_fp8_f32(w[2] * 256.f, w[3] * 256.f, hi8, true);
        const f32x2 d01 = __builtin_amdgcn_cvt_pk_f32_fp8(hi8, false), d23 = __builtin_amdgcn_cvt_pk_f32_fp8(hi8, true);
        lo8 = __builtin_amdgcn_cvt_pk_fp8_f32((w[0] * 256.f - d01[0]) * 16.f, (w[1] * 256.f - d01[1]) * 16.f, lo8, false); lo8 = __builtin_amdgcn_cvt_pk_fp8_f32((w[2] * 256.f - d23[0]) * 16.f, (w[3] * 256.f - d23[1]) * 16.f, lo8, true);
        { GAS unsigned* wp = (GAS unsigned*)((GAS unsigned char*)W + (size_t)(e >> 5) * 256 + (e & 31) * 4); wp[0] = hi8; wp[32] = lo8; }
    }
}
constexpr int PV_BLK = 1032, PV_WREG = 16640;
typedef int v2i_t __attribute__((ext_vector_type(2)));
__device__ __forceinline__ void pv_accum(const Args& a0, const Ctx& F0) {
    const Ctx F = fresh(F0); const Args a = fresh(a0);
    GAS unsigned char* ws = (GAS unsigned char*)a.ws; const int sl = (blockIdx.x & 7) >> 1, nrk = F.G >> 2, wr = ((blockIdx.x >> 3) * 2 + (blockIdx.x & 1)) * NWAVES + F.wave, lane = F.lane, g = lane >> 3, sub = lane & 7;
    const __amdgpu_buffer_rsrc_t tab = __builtin_amdgcn_make_buffer_rsrc((void*)(a.ws + WS_V + (size_t)sl * (PEXP * 128)), 0, PEXP * 128, 0x00020000);
    const GAS unsigned short* EI = (const GAS unsigned short*)(ws + WS_EIDX); const GAS unsigned char* W8 = ws + WS_WGT; GAS bf16* PO = (GAS bf16*)(ws + WS_PEERO);
    LAS unsigned char* wl = F.lds + F.wave * PV_WREG;
    const int m = lane & 15, kg = lane >> 4;
    LAS unsigned char* rdp = wl + PV_BLK * m + 128 * ((kg & 1) + 4 * (kg >> 1));
    const int g1 = (kg >> 1) + 2 * (kg & 1);
    const bool s0 = (m >> 1) == 0, s1 = (m >> 1) == 2, s2 = (m >> 1) == 4, s3 = (m >> 1) == 6;
    const int step = nrk * NWAVES;
#define PV_IDX(tk_, E0, E1, A0, A1) do { const int t_ = (tk_) < NT ? (tk_) : NT - 1; E0 = *(const GAS v4u*)(EI + (size_t)t_ * 128 + g * 16); E1 = *(const GAS v4u*)(EI + (size_t)t_ * 128 + g * 16 + 8); \
        A0 = *(const GAS v4u*)(W8 + (size_t)t_ * 256 + (m & 1) * 128 + 16 * g1); A1 = *(const GAS v4u*)(W8 + (size_t)t_ * 256 + (m & 1) * 128 + 64 + 16 * g1); } while (0)
#define PV_GATHER(E0, E1) do { const unsigned ew_[8] = {E0.x, E0.y, E0.z, E0.w, E1.x, E1.y, E1.z, E1.w}; \
        _Pragma("unroll") for (int j = 0; j < 16; ++j) { const unsigned idx = (j & 1) ? (ew_[j >> 1] >> 16) : (ew_[j >> 1] & 0xffffu); \
            __builtin_amdgcn_raw_ptr_buffer_load_lds(tab, (LAS void*)(wl + PV_BLK * j), 16, (int)(idx * 128u + (unsigned)sub * 16u), 0, 0, 0); } } while (0)
#define PV_SEL(S, A0, A1) (pg8::v8i_t){(int)(S ? A0.x : 0u), (int)(S ? A0.y : 0u), (int)(S ? A0.z : 0u), (int)(S ? A0.w : 0u), (int)(S ? A1.x : 0u), (int)(S ? A1.y : 0u), (int)(S ? A1.z : 0u), (int)(S ? A1.w : 0u)}
#define PV_RD(R, b_) const v2i_t R##a = __builtin_amdgcn_ds_read_tr4_b64_v2i32((LAS v2i_t*)(rdp + 8 * (b_))), R##b = __builtin_amdgcn_ds_read_tr4_b64_v2i32((LAS v2i_t*)(rdp + 256 + 8 * (b_)));
#define PV_RD4(P, q_) PV_RD(P##0, (q_)) PV_RD(P##1, 4 + (q_)) PV_RD(P##2, 8 + (q_)) PV_RD(P##3, 12 + (q_))
#define PV_MM(ACC, AQ, R) do { const pg8::v4i_t b4_ = (pg8::v4i_t){R##a[0], R##a[1], R##b[0], R##b[1]}; asm volatile("v_mfma_f32_16x16x128_f8f6f4 %0, %1, %2, %0 cbsz:0 blgp:4" : "+v"(ACC) : "v"(AQ), "v"(b4_)); } while (0)
#define PV_MM4(AQ, P) do { asm volatile("s_nop 4" ::: "memory"); PV_MM(acc0, AQ, P##0); PV_MM(acc1, AQ, P##1); PV_MM(acc2, AQ, P##2); PV_MM(acc3, AQ, P##3); } while (0)
#define PV_MATH(A0, A1) \
        const pg8::v8i_t aq0 = PV_SEL(s0, A0, A1), aq1 = PV_SEL(s1, A0, A1), aq2 = PV_SEL(s2, A0, A1), aq3 = PV_SEL(s3, A0, A1); \
        f32x4 acc0 = (f32x4){0.f, 0.f, 0.f, 0.f}, acc1 = acc0, acc2 = acc0, acc3 = acc0; \
        asm volatile("s_waitcnt vmcnt(0)" ::: "memory"); \
        PV_RD4(ra, 0) __builtin_amdgcn_sched_barrier(0); \
        asm volatile("s_waitcnt lgkmcnt(7)" ::: "memory"); PV_RD4(rb, 1) __builtin_amdgcn_sched_barrier(0);        \
        PV_MM4(aq0, ra); __builtin_amdgcn_sched_barrier(0); \
        asm volatile("s_waitcnt lgkmcnt(7)" ::: "memory"); PV_RD4(rc, 2) __builtin_amdgcn_sched_barrier(0); \
        PV_MM4(aq1, rb); __builtin_amdgcn_sched_barrier(0); \
        asm volatile("s_waitcnt lgkmcnt(7)" ::: "memory"); PV_RD4(rd, 3) __builtin_amdgcn_sched_barrier(0); \
        PV_MM4(aq2, rc); __builtin_amdgcn_sched_barrier(0); \
        asm volatile("s_waitcnt lgkmcnt(0)" ::: "memory");
#define PV_MATH2() \
        PV_MM4(aq3, rd); \
        asm volatile("s_nop 15\n\ts_nop 15" : "+v"(acc0), "+v"(acc1), "+v"(acc2), "+v"(acc3));
#define PV_STORE(tk_) \
        GAS unsigned char* po_ = (GAS unsigned char*)PO + (size_t)(tk_) * DM + sl * 256 + lane;        \
        po_[0] = (unsigned char)(__builtin_amdgcn_cvt_pk_fp8_f32((acc0[0] + acc0[1] * 0.0625f) * (16.f / 256.f), 0.f, 0u, false) & 0xffu); po_[64] = (unsigned char)(__builtin_amdgcn_cvt_pk_fp8_f32((acc1[0] + acc1[1] * 0.0625f) * (16.f / 256.f), 0.f, 0u, false) & 0xffu); \
        po_[128] = (unsigned char)(__builtin_amdgcn_cvt_pk_fp8_f32((acc2[0] + acc2[1] * 0.0625f) * (16.f / 256.f), 0.f, 0u, false) & 0xffu); po_[192] = (unsigned char)(__builtin_amdgcn_cvt_pk_fp8_f32((acc3[0] + acc3[1] * 0.0625f) * (16.f / 256.f), 0.f, 0u, false) & 0xffu);
    v4u e0, e1, a0w, a1w;
    PV_IDX(wr, e0, e1, a0w, a1w);
    if (wr < NT) PV_GATHER(e0, e1);
    for (int tk = wr; tk < NT; tk += step) {
        const v4u wa0 = a0w, wa1 = a1w;
        __builtin_amdgcn_sched_barrier(0);
        PV_IDX(tk + step, e0, e1, a0w, a1w);
        __builtin_amdgcn_sched_barrier(0);
        { PV_MATH(wa0, wa1)
          __builtin_amdgcn_sched_barrier(0);
          if (tk + step < NT) PV_GATHER(e0, e1);
          __builtin_amdgcn_sched_barrier(0);
          PV_MATH2()
          PV_STORE(tk) }
        __builtin_amdgcn_sched_barrier(0);
    }
    LBAR();
}
__device__ __forceinline__ void pf_final(const Args& a0, const Ctx& F0) {
    constexpr bool PEER = true, from_x1 = true;
    const Ctx F = fresh(F0); const Args a = fresh(a0); const GAS bf16* X1 = (const GAS bf16*)(a.ws + WS_X1); const GAS float* XF = (const GAS float*)a.x;
    const GAS float* mod = (const GAS float*)(a.ws + WS_MOD); const GAS bf16* PO = (const GAS bf16*)(a.ws + WS_PEERO);
    const int gw = F.vcu * NWAVES + F.wave, NGW = F.G * NWAVES, lane = F.lane;
    for (int t0 = 2 * gw; t0 < NT; t0 += 2 * NGW) {
        const int b = t0 >> 11; f32x4 xv[2][4]; unsigned pv[2][4];
#pragma unroll
        for (int r = 0; r < 2; ++r)
#pragma unroll
            for (int j = 0; j < 4; ++j) { const int k = 4 * lane + 256 * j; if (from_x1) { const v2u xw = *(const GAS v2u*)(X1 + (size_t)(t0 + r) * DM + k); xv[r][j] = (f32x4){bflo(xw.x), bfhi(xw.x), bflo(xw.y), bfhi(xw.y)}; } else xv[r][j] = *(const GAS f32x4*)(XF + (size_t)(t0 + r) * DM + k); if (PEER) pv[r][j] = *(const GAS unsigned*)((const GAS unsigned char*)PO + (size_t)(t0 + r) * DM + k); }
        f32x4 g2[4], fgv[4];
#pragma unroll
        for (int j = 0; j < 4; ++j) { const int k = 4 * lane + 256 * j; g2[j] = *(const GAS f32x4*)(mod + b * 6144 + 5120 + k); fgv[j] = *(const GAS f32x4*)((const GAS float*)a.final_g + k); }
#pragma unroll
        for (int r = 0; r < 2; ++r) { float ss = 0.f;
#pragma unroll
            for (int j = 0; j < 4; ++j) {
                if (PEER) { const f32x2 p01 = __builtin_amdgcn_cvt_pk_f32_fp8(pv[r][j], false), p23 = __builtin_amdgcn_cvt_pk_f32_fp8(pv[r][j], true); xv[r][j] = xv[r][j] + g2[j] * (f32x4){p01[0], p01[1], p23[0], p23[1]} * 0.0625f; }
                ss += (xv[r][j][0] * xv[r][j][0] + xv[r][j][1] * xv[r][j][1]) + (xv[r][j][2] * xv[r][j][2] + xv[r][j][3] * xv[r][j][3]); }
            const float rstd = __builtin_amdgcn_rsqf(wave_sum(ss) * (1.f / DM) + EPS);
#pragma unroll
            for (int j = 0; j < 4; ++j) { const int k = 4 * lane + 256 * j; *(GAS f32x4*)((GAS float*)a.out + (size_t)(t0 + r) * DM + k) = xv[r][j] * rstd * fgv[j]; } }
    }
}

__global__ void __launch_bounds__(NWAVES * 64, 2) hybrid_fwd(Args a_) {
    extern __shared__ __attribute__((aligned(16))) unsigned char lds[];
    Ctx F; F.lds = (LAS unsigned char*)lds; F.tid = threadIdx.x; F.lane = F.tid & 63; F.wave = __builtin_amdgcn_readfirstlane(F.tid >> 6);
    F.G = gridDim.x; { const int bx = blockIdx.x; F.vcu = (F.G % 8 == 0) ? (bx % 8) * (F.G / 8) + bx / 8 : bx; }
    volatile LAS unsigned* MISC = (volatile LAS unsigned*)(F.lds + LDSCTL_OFF);
    for (int u = F.tid; u < (LDS_BYTES - LDSCTL_OFF) / 4; u += NWAVES * 64) ((LAS unsigned*)(F.lds + LDSCTL_OFF))[u] = 0u;
    __syncthreads();
    unsigned* ctl = (unsigned*)(a_.ws + WS_CTL);
    (void)xcd_barrier_post(ctl + CW_BAR, MISC + 8);
#define GRID_BAR() do { const Args ab_ = fresh(a_); XcdBarrier bar_; bar_.bar = (unsigned*)(ab_.ws + WS_CTL) + CW_BAR; bar_.x = xb_xcc_id(); bar_.st = (volatile LAS unsigned*)((LAS unsigned char*)lds + LDSCTL_OFF) + 8; xcd_barrier(bar_, F.wave); } while (0)

    p0_prep(a_, F); GRID_BAR();
    p1_norm(a_, F); GRID_BAR();
    for (int jj = 0; jj < 6; ++jj) {
        const int job = jj < 3 ? (jj == 0 ? 2 : jj - 1) : jj;
        if (job == 3) { GRID_BAR(); p3_scan(a_, F); GRID_BAR(); p4_intra(a_, F); GRID_BAR(); }
        if (job == 4) GRID_BAR();
        if (job == 5) { GRID_BAR(); p7_norm(a_, F); GRID_BAR(); }
        const Args a = fresh(a_); pg8::Gemm g; EpiAll E; E.x = a.x; E.outf = a.out; E.ws = a.ws; E.mid_t = -1; pg8::StaticOrder S; bool f8 = false;
        const bf16* H = (const bf16*)((unsigned char*)a.out + DO_H); const bf16* H8 = (const bf16*)((unsigned char*)a.out + DO_H8);
        switch (job) {
            case 0: g = pg8::Gemm{(const bf16*)(a.ws + WS_WINS), H8, NPS, NT + NTC, DM / 2}; E.mode = EM_PROJS; f8 = true; break;
            case 1: g = pg8::Gemm{H8, (const bf16*)(a.ws + WS_WINN), NT + NTC, NPQ, DM / 2}; E.mode = EM_PROJN; f8 = true; break;
            case 2: g = pg8::Gemm{H8, (const bf16*)(a.ws + WS_WINN8), NT, NPG, DM / 2}; E.mode = EM_PROJG; f8 = true; break;
            case 3: g = pg8::Gemm{(const bf16*)(a.ws + WS_CAT), (const bf16*)(a.ws + WS_WPOOL), NT, DM, 768}; E.mode = EM_MERGE; E.mid_t = 4; f8 = true; break;
            case 4: g = pg8::Gemm{(const bf16*)(a.ws + WS_MERGED), (const bf16*)(a.ws + WS_WOUT), NT, DM, DM}; E.mode = EM_OUT; break;
            default: g = pg8::Gemm{(const bf16*)(a.ws + WS_HF), (const bf16*)(a.ws + WS_WEFF), NT, 2048, DM}; E.mode = EM_SCORE; break;
        }
        S.init(g.M, g.N, F.G, job == 1 ? (int)((blockIdx.x + (unsigned)(F.G >> 1)) % (unsigned)F.G) : (int)blockIdx.x);
        if (f8) pg8::gemm_phase<EpiAll, pg8::StaticOrder, true, true, true>(F.lds, g, S, E, F.wave);
        else pg8::gemm_phase<EpiAll, pg8::StaticOrder, true, true, false>(F.lds, g, S, E, F.wave);
    }
    GRID_BAR();
    p9_route(a_, F); GRID_BAR();
    pu_dots(a_, F); GRID_BAR();
    pr_weights(a_, F); GRID_BAR();
    pv_accum(a_, F); GRID_BAR();
    pf_final(a_, F);
}

extern "C" void kernel_launch(void* const* d_in, const int* in_sizes, int n_in, void* d_out, int out_size, void* d_ws, size_t ws_size, hipStream_t stream) {
    static int grid = 0;
    if (grid == 0) {
        if (n_in != 21 || in_sizes[0] != NT * DM || out_size != NT * DM || ws_size < WS_END) {
            fprintf(stderr, "kernel_launch: unexpected shapes: n_in %d in0 %d out %d ws %zu (need %zu)\n", n_in, n_in > 0 ? in_sizes[0] : -1, out_size, ws_size, (size_t)WS_END); grid = -1; return; }
        int dev = 0, cus = 0, per_cu = 0;
        if (hipGetDevice(&dev) != hipSuccess || hipDeviceGetAttribute(&cus, hipDeviceAttributeMultiprocessorCount, dev) != hipSuccess) { grid = -1; return; }
        if (hipFuncSetAttribute((const void*)hybrid_fwd, hipFuncAttributeMaxDynamicSharedMemorySize, LDS_BYTES) != hipSuccess) { fprintf(stderr, "kernel_launch: hipFuncSetAttribute failed\n"); grid = -1; return; }
        if (hipOccupancyMaxActiveBlocksPerMultiprocessor(&per_cu, (const void*)hybrid_fwd, NWAVES * 64, LDS_BYTES) != hipSuccess || per_cu < 1) { fprintf(stderr, "kernel_launch: occupancy query reports %d\n", per_cu); }
        (void)hipGetLastError();
        grid = cus;
    }
    if (grid < 0) return;
    if (hipMemsetAsync((char*)d_ws + WS_CTL, 0, CTL_ZERO_BYTES, stream) != hipSuccess) return;
    Args a{};
    const float** ap = (const float**)&a;
    for (int i = 0; i < 21; ++i) ap[i] = (const float*)d_in[i];
    a.out = (float*)d_out; a.ws = (unsigned char*)d_ws;
    hipLaunchKernelGGL(hybrid_fwd, dim3(grid), dim3(NWAVES * 64), LDS_BYTES, stream, a);
}
```
